# Optimizing an MI355X kernel written in HIP

```python
import math, functools
import jax, jax.numpy as jnp
from jax import lax
import numpy as np

D_MODEL = 1024
BATCH = 16
SEQ = 4096
DEPTH = 1
DEC_BATCH = 128
DEC_SEQ = 8
PAST_LEN = 8192
PAGE_SIZE = 128

D_MIX = D_MODEL
HD_A = 64
H_A = (D_MIX // 2) // HD_A
D_A = H_A * HD_A
H_B = 4
DV_B = (D_MIX - D_A) // H_B
DK_B = DV_B // 2
D_B = H_B * DV_B
GATE_RANK = 16
GATE_TAU = 16.0
GLA_CHUNK = 64
DILATED = ((128, 1), (512, 4), (2048, 16))
MAX_WINDOW = 2048
BAND_BLOCK = 128
ROPE_THETA = 10000.0
EPS = 1e-6
SPLIT_SIZES = (D_A, D_A, D_A, H_B * DK_B, H_B * DK_B, D_B, GATE_RANK, D_A, D_B)
D_IN = sum(SPLIT_SIZES)

kernel_name = 'hymba_dilated_swa_gla_step'


def split_points():
    return [int(i) for i in np.cumsum(SPLIT_SIZES)[:-1]]


def rmsnorm(x, g):
    xf = x.astype(jnp.float32)
    y = xf * lax.rsqrt(jnp.mean(xf * xf, axis=-1, keepdims=True) + EPS)
    return (y * g.astype(jnp.float32)).astype(x.dtype)


def rope(x, pos):
    half = x.shape[-1] // 2
    inv_freq = ROPE_THETA ** (-jnp.arange(half, dtype=jnp.float32) / half)
    ang = pos.astype(jnp.float32)[:, None] * inv_freq[None, :]
    cos = jnp.cos(ang)[None, :, None, :]
    sin = jnp.sin(ang)[None, :, None, :]
    xf = x.astype(jnp.float32)
    x1, x2 = xf[..., :half], xf[..., half:]
    return jnp.concatenate([x1 * cos - x2 * sin, x2 * cos + x1 * sin], axis=-1).astype(x.dtype)


def softmax_attend(s, v, out_spec):
    m = jnp.max(s, axis=-1, keepdims=True)
    p = jnp.exp(s - m)
    den = jnp.sum(p, axis=-1)
    o = jnp.einsum(out_spec, p, v) / den[..., None]
    return o, m[..., 0] + jnp.log(den)


def dilated_branch_prompt(q, k, v, window, dil):
    B, S, H, hd = q.shape
    n_keys = window // dil + 1
    lm = S // dil
    nb = -(-lm // BAND_BLOCK)
    lp = nb * BAND_BLOCK

    def by_residue(a):
        a = a.reshape(B, lm, dil, H, hd).transpose(0, 2, 1, 3, 4)
        a = jnp.pad(a, ((0, 0), (0, 0), (0, lp - lm), (0, 0), (0, 0)))
        return a.reshape(B, dil, nb, BAND_BLOCK, H, hd)

    def with_prev(a):
        prev = jnp.concatenate([jnp.zeros_like(a[:, :, :1]), a[:, :, :-1]], axis=2)
        return jnp.concatenate([prev, a], axis=3)

    qr = by_residue(q)
    kk = with_prev(by_residue(k))
    vv = with_prev(by_residue(v))
    qi = jnp.arange(BAND_BLOCK)[:, None] + BAND_BLOCK
    ki = jnp.arange(2 * BAND_BLOCK)[None, :]
    dist = qi - ki
    key_m = (jnp.arange(nb)[:, None, None] - 1) * BAND_BLOCK + ki[None]
    valid = (dist >= 0) & (dist < n_keys) & (key_m >= 0)
    s = jnp.einsum('brnqhd,brnkhd->brnqhk', qr, kk) * (hd ** -0.5)
    s = jnp.where(valid[None, None, :, :, None, :], s, -jnp.inf)
    o, lse = softmax_attend(s, vv, 'brnqhk,brnkhd->brnqhd')
    o = o.reshape(B, dil, lp, H, hd)[:, :, :lm].transpose(0, 2, 1, 3, 4).reshape(B, S, H, hd)
    lse = lse.reshape(B, dil, lp, H)[:, :, :lm].transpose(0, 2, 1, 3).reshape(B, S, H)
    return o, lse


def dilated_branch_sample(q, k_buf, v_buf, window, dil):
    T = q.shape[1]
    W = k_buf.shape[1] - T
    hd = q.shape[-1]
    n_keys = window // dil + 1
    idx = W + jnp.arange(T)[:, None] - dil * jnp.arange(n_keys)[None, :]
    valid = idx >= 0
    idx = jnp.maximum(idx, 0)
    kg = k_buf[:, idx]
    vg = v_buf[:, idx]
    s = jnp.einsum('bthd,btnhd->bthn', q, kg) * (hd ** -0.5)
    s = jnp.where(valid[None, :, None, :], s, -jnp.inf)
    return softmax_attend(s, vg, 'bthn,btnhd->bthd')


def dilated_mixture(results):
    outs = jnp.stack([r[0] for r in results], axis=0)
    lses = jnp.stack([r[1] for r in results], axis=0)
    alpha = jax.nn.softmax(lses, axis=0)
    return jnp.einsum('gblh,gblhd->blhd', alpha, outs)


def attend_prompt(q, k, v):
    qf, kf, vf = (a.astype(jnp.float32) for a in (q, k, v))
    return dilated_mixture([dilated_branch_prompt(qf, kf, vf, w, d) for w, d in DILATED])


def attend_sample(k_past, v_past, q, k, v):
    qf = q.astype(jnp.float32)
    k_buf = jnp.concatenate([k_past.astype(jnp.float32), k.astype(jnp.float32)], axis=1)
    v_buf = jnp.concatenate([v_past.astype(jnp.float32), v.astype(jnp.float32)], axis=1)
    return dilated_mixture([dilated_branch_sample(qf, k_buf, v_buf, w, d) for w, d in DILATED])


def gla_chunked(q, k, v, log_a, s0):
    B, L, H, dk = q.shape
    dv = v.shape[-1]
    c = math.gcd(L, GLA_CHUNK)
    n = L // c

    def to_chunks(a):
        return a.astype(jnp.float32).reshape(B, n, c, H, a.shape[-1]).transpose(1, 0, 3, 2, 4)

    causal = jnp.tril(jnp.ones((c, c), dtype=bool))

    def step(state, xs):
        qc, kc, vc, gc = xs
        b = jnp.cumsum(gc, axis=2)
        diff = b[:, :, :, None, :] - b[:, :, None, :, :]
        decay = jnp.exp(jnp.where(causal[:, :, None], diff, -jnp.inf))
        scores = jnp.einsum('bhtk,bhsk,bhtsk->bhts', qc, kc, decay)
        o = (jnp.einsum('bhts,bhsv->bhtv', scores, vc)
             + jnp.einsum('bhtk,bhkv->bhtv', qc * jnp.exp(b), state))
        b_last = b[:, :, -1]
        state = (jnp.exp(b_last)[..., None] * state
                 + jnp.einsum('bhsk,bhsv->bhkv', kc * jnp.exp(b_last[:, :, None] - b), vc))
        return state, o

    s_fin, o = lax.scan(step, s0.astype(jnp.float32),
                        (to_chunks(q), to_chunks(k), to_chunks(v), to_chunks(log_a)))
    return o.transpose(1, 0, 3, 2, 4).reshape(B, L, H, dv), s_fin


def mixer_layer(x, pos, attend, s0, norm_w, w_in, w_gate_up, b_gate, q_norm_w, k_norm_w,
                gla_norm_w, w_out):
    B, L, _ = x.shape
    h = rmsnorm(x, norm_w)
    z = h @ w_in
    q, k, v, qb, kb, vb, g_lr, gate_a, gate_b = jnp.split(z, split_points(), axis=-1)
    heads = lambda a, nh: a.reshape(B, L, nh, -1)
    q = rope(rmsnorm(heads(q, H_A), q_norm_w), pos)
    k = rope(rmsnorm(heads(k, H_A), k_norm_w), pos)
    v = heads(v, H_A)
    o_a = attend(q, k, v)
    log_a = jax.nn.log_sigmoid((g_lr @ w_gate_up + b_gate).astype(jnp.float32)) / GATE_TAU
    o_b, s_fin = gla_chunked(heads(qb, H_B) * (DK_B ** -0.5), heads(kb, H_B), heads(vb, H_B),
                             heads(log_a, H_B), s0)
    o_b = rmsnorm(o_b, gla_norm_w)
    mixed = jnp.concatenate(
        [o_a.reshape(B, L, D_A) * jax.nn.silu(gate_a.astype(jnp.float32)),
         o_b.reshape(B, L, D_B) * jax.nn.silu(gate_b.astype(jnp.float32))], axis=-1)
    y = x + mixed.astype(x.dtype) @ w_out
    return y, k, v, s_fin


def setup_inputs(seed: int = 0) -> dict:
    key = jax.random.key(seed)
    ks = jax.random.split(key, 13)
    win = min(MAX_WINDOW, PAST_LEN)
    nrm = lambda kk, shape, scale: scale * jax.random.normal(kk, shape, dtype=jnp.float32)
    return {
        'x_prompt': nrm(ks[0], (BATCH, SEQ, D_MODEL), 1.0),
        'x_sample': nrm(ks[1], (DEC_BATCH, DEC_SEQ, D_MODEL), 1.0),
        'cache_k_win': nrm(ks[2], (DEPTH, DEC_BATCH, win, H_A, HD_A), 1.0),
        'cache_v_win': nrm(ks[3], (DEPTH, DEC_BATCH, win, H_A, HD_A), 1.0),
        'state_gla': nrm(ks[4], (DEPTH, DEC_BATCH, H_B, DK_B, DV_B), 1.0),
        'norm_w': 1.0 + nrm(ks[5], (DEPTH, D_MODEL), 0.02),
        'w_in': nrm(ks[6], (DEPTH, D_MODEL, D_IN), D_MODEL ** -0.5),
        'w_gate_up': nrm(ks[7], (DEPTH, GATE_RANK, H_B * DK_B), GATE_RANK ** -0.5),
        'b_gate': nrm(ks[8], (DEPTH, H_B * DK_B), 0.1),
        'q_norm_w': 1.0 + nrm(ks[9], (DEPTH, HD_A), 0.02),
        'k_norm_w': 1.0 + nrm(ks[10], (DEPTH, HD_A), 0.02),
        'gla_norm_w': 1.0 + nrm(ks[11], (DEPTH, DV_B), 0.02),
        'w_out': nrm(ks[12], (DEPTH, D_MIX, D_MODEL), D_MIX ** -0.5),
    }


def reference(x_prompt, x_sample, cache_k_win, cache_v_win, state_gla, norm_w, w_in, w_gate_up,
              b_gate, q_norm_w, k_norm_w, gla_norm_w, w_out):
    bp, sp, _ = x_prompt.shape
    bs, ts, _ = x_sample.shape
    pos_p = jnp.arange(sp)
    pos_s = PAST_LEN + jnp.arange(ts)
    keep_p = min(MAX_WINDOW, sp)
    hp, hs = x_prompt, x_sample
    kp_l, vp_l, sp_l, ks_l, vs_l, ss_l = [], [], [], [], [], []
    for layer in range(DEPTH):
        params = (norm_w[layer], w_in[layer], w_gate_up[layer], b_gate[layer], q_norm_w[layer],
                  k_norm_w[layer], gla_norm_w[layer], w_out[layer])
        s0 = jnp.zeros((bp, H_B, DK_B, DV_B), dtype=jnp.float32)
        hp, kp, vp, st_p = mixer_layer(hp, pos_p, attend_prompt, s0, *params)
        att_s = functools.partial(attend_sample, cache_k_win[layer], cache_v_win[layer])
        hs, kn, vn, st_s = mixer_layer(hs, pos_s, att_s, state_gla[layer], *params)
        kp_l.append(kp[:, sp - keep_p:])
        vp_l.append(vp[:, sp - keep_p:])
        sp_l.append(st_p.astype(state_gla.dtype))
        ks_l.append(kn)
        vs_l.append(vn)
        ss_l.append(st_s.astype(state_gla.dtype))
    return (hp, hs, jnp.stack(kp_l), jnp.stack(vp_l), jnp.stack(sp_l),
            jnp.stack(ks_l), jnp.stack(vs_l), jnp.stack(ss_l))
```

```cpp
#include <hip/hip_runtime.h>
#include <cstdio>
#include <cstdint>
#include <cmath>
#define MK_N_LAUNCHES 1
namespace pg8 {
#define PG8_LAS __attribute__((address_space(3)))
typedef unsigned short bf16_t;
typedef short bf16x8 __attribute__((ext_vector_type(8)));
typedef float f32x4 __attribute__((ext_vector_type(4)));
typedef unsigned u32x4 __attribute__((ext_vector_type(4)));
constexpr int BM = 256, BK = 64, HALF = 128, HTB = HALF * BK * 2  , STAGE_BYTES = 8 * HTB, NXCD = 8, WGM = 8;

__host__ __device__ __forceinline__ int lds_byte(int r, int c) { const int st = (r >> 4) * 2 + (c >> 5), rr = r & 15, cc = c & 31, ob = rr * 64 + cc * 2; return st * 1024 + (ob ^ (((ob >> 9) & 1) << 5)); }
__host__ __device__ __forceinline__ void stage_rc(int b, int& R, int& C) { const int st = b / 1024, sb = b % 1024, swz = sb ^ (((sb >> 9) & 1) << 5); R = (st >> 1) * 16 + swz / 64; C = (st & 1) * 32 + (swz % 64) / 2; }
__host__ __device__ __forceinline__ int perm32(int rho) { const int n = rho >> 4, i = rho & 15; return 8 * (i >> 2) + 4 * n + (i & 3); }

struct Unit { int pm, pn; };
struct Gemm { const bf16_t* A; const bf16_t* Bt; int M, N, K; };

struct StaticOrder {
    int nM, nN, nwg, G, c;
    __host__ __device__ void init(int M, int N, int G_, int c_) { nM = M / BM; nN = N / BM; nwg = nM * nN; G = G_; c = c_; }
    __host__ __device__ bool next(int i, Unit& u) const {
        const long L = (long)i * G + c; if (L >= nwg) return false;
        int wgid = (int)L; { const int q = nwg / NXCD, r = nwg % NXCD, xcd = wgid % NXCD, off = wgid / NXCD; wgid = (xcd < r ? xcd * (q + 1) : r * (q + 1) + (xcd - r) * q) + off; }
        const int nig = WGM * nN, gid = wgid / nig, fm = gid * WGM, gsz = (nM - fm) < WGM ? (nM - fm) : WGM;
        u.pm = fm + ((wgid % nig) % gsz); u.pn = (wgid % nig) / gsz; return true;
    }
    __device__ __forceinline__ void a_ready(const Unit&) const {}
    __device__ __forceinline__ void done(const Unit&) const {}
};

__device__ __forceinline__ unsigned cvt_pk_bf16(float lo, float hi) { unsigned r; asm volatile("v_cvt_pk_bf16_f32 %0, %1, %2" : "=v"(r) : "v"(lo), "v"(hi)); return r; }
template <class Epi, class Sched, bool ALIGN_EPI = false, bool SP2 = false>
__device__ __forceinline__ void gemm_phase(PG8_LAS unsigned char* lds, const Gemm g, const Sched& S, const Epi& E) {
    const int tid = threadIdx.x, wid = __builtin_amdgcn_readfirstlane(tid >> 6), lane = tid & 63, wr = wid >> 2, wc = wid & 3, fr = lane & 15, fq = lane >> 4;
    const int K = g.K, nt = K / BK;
    unsigned voffA[2], voffB[2];
#pragma unroll
    for (int i = 0; i < 2; ++i) { int R, C; stage_rc(tid * 16 + i * 8192, R, C); const int Rb = Epi::PERM ? ((R & ~31) + perm32(R & 31)) : R;
        voffA[i] = (unsigned)(R * K + C) * 2u; voffB[i] = (unsigned)(Rb * K + C) * 2u; }
    const size_t kstep = (size_t)(BK * 2);
    const size_t hstep = (size_t)HALF * K * 2;
    const size_t tstep = 2 * hstep;
    const unsigned ldsw = (unsigned)wid * 1024u;
    const int aoff = lds_byte(wr * 64 + fr, fq * 8), boff = lds_byte(wc * 32 + fr, fq * 8);
#define PG8_SA(b, h) (((b) * 2 + (h)) * HTB)
#define PG8_SB(b, h) ((4 + (b) * 2 + (h)) * HTB)
#define PG8_STAGE(bufoff, gbase, voff) do { _Pragma("unroll") for (int _i = 0; _i < 2; ++_i) \
        __builtin_amdgcn_global_load_lds((const unsigned*)((const char*)(gbase) + (voff)[_i]), (PG8_LAS unsigned*)(lds + (bufoff) + ldsw + _i * 8192), 16, 0, 0); } while (0)
#define PG8_LDA(dst, b, h) do { _Pragma("unroll") for (int m = 0; m < 4; ++m) _Pragma("unroll") for (int k = 0; k < 2; ++k) dst[m][k] = *(const PG8_LAS bf16x8*)(lds + PG8_SA(b, h) + aoff + m * 2048 + k * 1024); } while (0)
#define PG8_LDB(dst, b, h) do { _Pragma("unroll") for (int n = 0; n < 2; ++n) _Pragma("unroll") for (int k = 0; k < 2; ++k) dst[n][k] = *(const PG8_LAS bf16x8*)(lds + PG8_SB(b, h) + boff + n * 2048 + k * 1024); } while (0)
#define PG8_MMA(ai, bj, At, Bt) do { __builtin_amdgcn_s_setprio(1); _Pragma("unroll") for (int m = 0; m < 4; ++m) _Pragma("unroll") for (int n = 0; n < 2; ++n) _Pragma("unroll") for (int k = 0; k < 2; ++k) \
        acc[ai][bj][m][n] = __builtin_amdgcn_mfma_f32_16x16x32_bf16(Bt[n][k], At[m][k], acc[ai][bj][m][n], 0, 0, 0); __builtin_amdgcn_s_setprio(0); } while (0)
#define PG8_WAIT_V(n) asm volatile("s_waitcnt vmcnt(" #n ")" ::: "memory")
#define PG8_WAIT_L(n) asm volatile("s_waitcnt lgkmcnt(" #n ")" ::: "memory")
#define PG8_BAR __builtin_amdgcn_s_barrier()
#define PG8_SCHED __builtin_amdgcn_sched_barrier(0)
    Unit cur, nxt; int ui = 0;
    if (!S.next(0, cur)) return;
    f32x4 acc[2][2][4][2];
#pragma unroll
    for (int a = 0; a < 2; ++a)
#pragma unroll
        for (int b = 0; b < 2; ++b)
#pragma unroll
            for (int m = 0; m < 4; ++m)
#pragma unroll
                for (int n = 0; n < 2; ++n) acc[a][b][m][n] = (f32x4){0.f, 0.f, 0.f, 0.f};
    bf16x8 At[4][2], B0[2][2], B1[2][2];
    const char* cA = (const char*)g.A + (size_t)cur.pm * tstep; const char* cB = (const char*)g.Bt + (size_t)cur.pn * tstep;
    S.a_ready(cur);
    if constexpr (SP2) {
        PG8_STAGE(PG8_SB(0, 0), cB, voffB); PG8_STAGE(PG8_SB(0, 1), cB + hstep, voffB); PG8_STAGE(PG8_SA(0, 0), cA, voffA); PG8_STAGE(PG8_SA(0, 1), cA + hstep, voffA);
        if (wr == 1) PG8_BAR;
        PG8_WAIT_V(2); PG8_BAR;
        PG8_STAGE(PG8_SB(1, 0), cB + kstep, voffB); PG8_STAGE(PG8_SA(1, 0), cA + kstep, voffA); PG8_STAGE(PG8_SB(1, 1), cB + hstep + kstep, voffB);
        PG8_WAIT_V(6); PG8_BAR;
    } else {
        PG8_STAGE(PG8_SB(0, 0), cB, voffB); PG8_STAGE(PG8_SA(0, 0), cA, voffA); PG8_STAGE(PG8_SB(0, 1), cB + hstep, voffB); PG8_STAGE(PG8_SA(0, 1), cA + hstep, voffA);
        if (wr == 1) PG8_BAR;
        PG8_WAIT_V(4); PG8_BAR;
        PG8_STAGE(PG8_SB(1, 0), cB + kstep, voffB); PG8_STAGE(PG8_SA(1, 0), cA + kstep, voffA); PG8_STAGE(PG8_SB(1, 1), cB + hstep + kstep, voffB);
        PG8_WAIT_V(6); PG8_BAR;
    }
    for (;;) {
        const bool has_next = S.next(ui + 1, nxt);
        const char* nA = has_next ? (const char*)g.A + (size_t)nxt.pm * tstep : cA; const char* nB = has_next ? (const char*)g.Bt + (size_t)nxt.pn * tstep : cB;
        for (int t = 0; t < nt; t += 2) {
            const bool last = (t == nt - 2);
            const char* a1 = cA + (size_t)(t + 1) * kstep;
            const char* a2 = last ? nA : cA + (size_t)(t + 2) * kstep; const char* b2 = last ? nB : cB + (size_t)(t + 2) * kstep;
            const char* a3 = a2 + kstep; const char* b3 = b2 + kstep;
            if (last && has_next) S.a_ready(nxt);
            if constexpr (SP2) {
            PG8_LDB(B0, 0, 0); PG8_LDB(B1, 0, 1); PG8_SCHED; PG8_LDA(At, 0, 0); PG8_STAGE(PG8_SA(1, 1), a1 + hstep, voffA);
            PG8_WAIT_V(8); PG8_WAIT_L(0); PG8_BAR; PG8_MMA(0, 0, At, B0); PG8_MMA(0, 1, At, B1); PG8_BAR; PG8_SCHED;
            PG8_LDA(At, 0, 1); PG8_STAGE(PG8_SB(0, 0), b2, voffB); PG8_STAGE(PG8_SB(0, 1), b2 + hstep, voffB); PG8_STAGE(PG8_SA(0, 0), a2, voffA);
            PG8_WAIT_V(8); PG8_WAIT_L(0); PG8_BAR; PG8_MMA(1, 0, At, B0); PG8_MMA(1, 1, At, B1); PG8_BAR; PG8_SCHED;
            PG8_LDB(B0, 1, 0); PG8_LDB(B1, 1, 1); PG8_SCHED; PG8_LDA(At, 1, 0); PG8_STAGE(PG8_SA(0, 1), a2 + hstep, voffA);
            PG8_WAIT_V(8); PG8_WAIT_L(0); PG8_BAR; PG8_MMA(0, 0, At, B0); PG8_MMA(0, 1, At, B1); PG8_BAR; PG8_SCHED;
            PG8_LDA(At, 1, 1); PG8_STAGE(PG8_SB(1, 0), b3, voffB); PG8_STAGE(PG8_SB(1, 1), b3 + hstep, voffB); PG8_STAGE(PG8_SA(1, 0), a3, voffA);
            PG8_WAIT_V(8); PG8_WAIT_L(0); PG8_BAR; PG8_MMA(1, 0, At, B0); PG8_MMA(1, 1, At, B1); PG8_BAR; PG8_SCHED;
            } else {
            PG8_LDB(B0, 0, 0); PG8_SCHED; PG8_LDA(At, 0, 0); PG8_STAGE(PG8_SA(1, 1), a1 + hstep, voffA);
            PG8_WAIT_L(8); PG8_BAR; PG8_WAIT_L(0); PG8_MMA(0, 0, At, B0); PG8_BAR; PG8_SCHED;
            PG8_LDB(B1, 0, 1); PG8_STAGE(PG8_SB(0, 0), b2, voffB);
            PG8_BAR; PG8_WAIT_L(0); PG8_MMA(0, 1, At, B1); PG8_BAR;
            PG8_LDA(At, 0, 1); PG8_STAGE(PG8_SA(0, 0), a2, voffA);
            PG8_BAR; PG8_WAIT_L(0); PG8_MMA(1, 0, At, B0); PG8_BAR; PG8_SCHED;
            PG8_STAGE(PG8_SB(0, 1), b2 + hstep, voffB);
            PG8_WAIT_V(6); PG8_BAR; PG8_MMA(1, 1, At, B1); PG8_BAR;
            PG8_LDB(B0, 1, 0); PG8_SCHED; PG8_LDA(At, 1, 0); PG8_STAGE(PG8_SA(0, 1), a2 + hstep, voffA);
            PG8_WAIT_L(8); PG8_BAR; PG8_WAIT_L(0); PG8_MMA(0, 0, At, B0); PG8_BAR; PG8_SCHED;
            PG8_LDB(B1, 1, 1); PG8_STAGE(PG8_SB(1, 0), b3, voffB);
            PG8_BAR; PG8_WAIT_L(0); PG8_MMA(0, 1, At, B1); PG8_BAR;
            PG8_LDA(At, 1, 1); PG8_STAGE(PG8_SA(1, 0), a3, voffA);
            PG8_BAR; PG8_WAIT_L(0); PG8_MMA(1, 0, At, B0); PG8_BAR; PG8_SCHED;
            PG8_STAGE(PG8_SB(1, 1), b3 + hstep, voffB);
            PG8_WAIT_V(6); PG8_BAR; PG8_MMA(1, 1, At, B1); PG8_BAR;
            }
        }
        if constexpr (ALIGN_EPI) { if (wr == 0) PG8_BAR; }
        if constexpr (!Epi::AFTER_DRAIN) { E(acc, cur, wr, wc, fr, fq); S.done(cur); }
        if (!has_next) break;
#pragma unroll
        for (int a = 0; a < 2; ++a)
#pragma unroll
            for (int b = 0; b < 2; ++b)
#pragma unroll
                for (int m = 0; m < 4; ++m)
#pragma unroll
                    for (int n = 0; n < 2; ++n) acc[a][b][m][n] = (f32x4){0.f, 0.f, 0.f, 0.f};
        cur = nxt; cA = nA; cB = nB; ++ui;
        if constexpr (ALIGN_EPI) { if (wr == 1) PG8_BAR; }
    }
    PG8_WAIT_V(0);
    if constexpr (!ALIGN_EPI) { if (wr == 0) PG8_BAR; }
    PG8_BAR;
    if constexpr (Epi::AFTER_DRAIN) { E.fused(acc, cur, wr, wc, fr, fq, lds, wid, lane); S.done(cur); }
#undef PG8_SA
#undef PG8_SB
#undef PG8_STAGE
#undef PG8_LDA
#undef PG8_LDB
#undef PG8_MMA
#undef PG8_WAIT_V
#undef PG8_WAIT_L
#undef PG8_BAR
#undef PG8_SCHED
}
}
constexpr int NWAVES = 8;
constexpr int DM = 1024, NB = 16, SEQ = 4096, MP = NB * SEQ  , SB = 128, ST = 8, MS = SB * ST  , MTOT = MP + MS  ;
constexpr int NIN = 3840;
constexpr int HA = 8, HD = 64, DA = 512, HB = 4, DKB = 64, DVB = 128, DBB = 512, RANK = 16, WIN = 2048, PAST = 8192;
constexpr float EPS = 1e-6f;
constexpr float LOG2E = 1.4426950408889634f;
constexpr float QSCALE = 0.125f * LOG2E;
constexpr size_t OUT_YP = 0, OUT_YS = OUT_YP + (size_t)MP * DM, OUT_KWIN = OUT_YS + (size_t)MS * DM, OUT_VWIN = OUT_KWIN + (size_t)NB * WIN * DA,
                 OUT_SP = OUT_VWIN + (size_t)NB * WIN * DA, OUT_KNEW = OUT_SP + (size_t)NB * HB * DKB * DVB, OUT_VNEW = OUT_KNEW + (size_t)MS * DA,
                 OUT_SS = OUT_VNEW + (size_t)MS * DA, OUT_END = OUT_SS + (size_t)SB * HB * DKB * DVB;
constexpr size_t MiB = 1u << 20;
constexpr size_t WS_CTL = 0, CTL_ZERO_BYTES = 1 * MiB;
constexpr size_t WS_WIN = 2 * MiB;
constexpr size_t WS_WOUT = 10 * MiB;
constexpr size_t WS_ROPE = 12 * MiB;
constexpr size_t WS_RSTD = 14 * MiB;
constexpr size_t WS_SCAL = 15 * MiB;
constexpr size_t WS_XB = 16 * MiB;
constexpr size_t WS_Q = 160 * MiB, WS_K = 228 * MiB, WS_V = 296 * MiB;
constexpr size_t WS_QB = 364 * MiB, WS_KB = 398 * MiB;
constexpr size_t WS_VB = 432 * MiB;
constexpr size_t WS_LOGA = 500 * MiB;
constexpr size_t WS_GA = 568 * MiB, WS_GB = 636 * MiB;
constexpr size_t WS_OPART = 704 * MiB;
constexpr size_t WS_LPART = 900 * MiB;
constexpr size_t WS_MIX = 908 * MiB;
constexpr size_t WS_END = 1040 * MiB;
constexpr size_t OPART_STRIDE = (size_t)MP * DA;
constexpr size_t LPART_STRIDE = (size_t)MP * HA;
constexpr int CW_TMO = 0, CW_CODE = 1;
constexpr int CW_TICKET = 64;
constexpr int CW_BAR = 4096;
constexpr int RING_OFF = 0, RING_BYTES = 131072;
constexpr int LDSCTL_OFF = RING_BYTES, MISC_OFF = LDSCTL_OFF + 320;
constexpr int LDS_BYTES = 147456;
#define GAS __attribute__((address_space(1)))
#define LAS __attribute__((address_space(3)))
typedef unsigned short bf16;
typedef unsigned v4u __attribute__((ext_vector_type(4)));
typedef unsigned v2u __attribute__((ext_vector_type(2)));
typedef float f32x4 __attribute__((ext_vector_type(4)));
typedef float f32x2 __attribute__((ext_vector_type(2)));
typedef float f32x16 __attribute__((ext_vector_type(16)));
typedef short bf16x8 __attribute__((ext_vector_type(8)));
typedef short s16x4 __attribute__((ext_vector_type(4)));
typedef GAS unsigned gu32;
#define RLX_AGENT __ATOMIC_RELAXED, __HIP_MEMORY_SCOPE_AGENT
#define LDS_WAIT() asm volatile("s_waitcnt lgkmcnt(0)" ::: "memory")
#define VM_WAIT() asm volatile("s_waitcnt vmcnt(0)" ::: "memory")
#define LBAR() do { asm volatile("s_waitcnt lgkmcnt(0)" ::: "memory"); __builtin_amdgcn_s_barrier(); asm volatile("" ::: "memory"); } while (0)
__device__ __forceinline__ unsigned f2bf(float f) { unsigned u = __builtin_bit_cast(unsigned, f); return (u + 0x7fffu + ((u >> 16) & 1u)) >> 16; }
__device__ __forceinline__ unsigned pk2(float lo, float hi) { typedef float f2 __attribute__((ext_vector_type(2))); typedef __bf16 b2 __attribute__((ext_vector_type(2))); f2 v = {lo, hi}; b2 b = __builtin_convertvector(v, b2); return __builtin_bit_cast(unsigned, b); }
__device__ __forceinline__ float bflo(unsigned u) { return __builtin_bit_cast(float, u << 16); }
__device__ __forceinline__ float bfhi(unsigned u) { return __builtin_bit_cast(float, u & 0xffff0000u); }
__device__ __forceinline__ v4u pack8(const f32x4 a, const f32x4 b) { v4u w; w.x = pk2(a[0], a[1]); w.y = pk2(a[2], a[3]); w.z = pk2(b[0], b[1]); w.w = pk2(b[2], b[3]); return w; }
__device__ __forceinline__ float wave_sum(float v) {
#pragma unroll
    for (int o = 1; o < 64; o <<= 1) v += __shfl_xor(v, o);
    return v;
}
__device__ __forceinline__ float wave_max(float v) {
#pragma unroll
    for (int o = 1; o < 64; o <<= 1) v = fmaxf(v, __shfl_xor(v, o));
    return v;
}
__device__ __forceinline__ float fast_exp2(float x) { return __builtin_amdgcn_exp2f(x); }
__device__ __forceinline__ float fast_exp(float x) { return __builtin_amdgcn_exp2f(x * LOG2E); }
__device__ __forceinline__ float silu_f(float x) { return x * __builtin_amdgcn_rcpf(1.0f + fast_exp(-x)); }
struct EpiIn {
    static constexpr bool PERM = true, AFTER_DRAIN = false;
    const float* rstd; const float* rope; const float* nwb  ; const float* bgate;
    unsigned char* ws; float* out;
    __device__ __forceinline__ void operator()(const f32x4 (&acc)[2][2][4][2], const pg8::Unit& u, int wr, int wc, int fr, int fq) const {
        const int pn = u.pn, pm = u.pm;
        const bool sample = pm >= (MP / 256);
        if (pn < 4) {
            const int head = 4 * (pn & 1) + wc; const bool isq = pn < 2;
            const float* nw = nwb + (isq ? 0 : 64);
            f32x4 w[2][2];
#pragma unroll
            for (int bj = 0; bj < 2; ++bj)
#pragma unroll
                for (int n = 0; n < 2; ++n) w[bj][n] = *(const f32x4*)(nw + 32 * bj + 8 * fq + 4 * n);
            bf16* dst = (bf16*)(ws + (isq ? WS_Q : WS_K));
            const bool wout = !isq && (sample || (pm & 15) >= 8);
#pragma unroll
            for (int ai = 0; ai < 2; ++ai)
#pragma unroll
                for (int m = 0; m < 4; ++m) {
                    const int rit = 128 * ai + 64 * wr + 16 * m + fr, row = 256 * pm + rit;
                    const float rs = rstd[row];
                    f32x4 x[2][2]; float ss = 0.f;
#pragma unroll
                    for (int bj = 0; bj < 2; ++bj)
#pragma unroll
                        for (int n = 0; n < 2; ++n) { x[bj][n] = acc[ai][bj][m][n] * rs; const f32x4 t = x[bj][n]; ss += (t[0] * t[0] + t[1] * t[1]) + (t[2] * t[2] + t[3] * t[3]); }
                    ss += __shfl_xor(ss, 16); ss += __shfl_xor(ss, 32);
                    const float rn = __builtin_amdgcn_rsqf(ss * (1.0f / 64.0f) + EPS);
                    const int ri = sample ? (SEQ + (rit & 7)) : (256 * (pm & 15) + rit);
                    const f32x4* tp = (const f32x4*)(rope + (size_t)ri * 64 + 16 * fq);
                    f32x4 o1[2], o2[2];
#pragma unroll
                    for (int n = 0; n < 2; ++n) {
                        const f32x4 ta = tp[2 * n], tb = tp[2 * n + 1];
                        const f32x4 y1 = x[0][n] * rn * w[0][n], y2 = x[1][n] * rn * w[1][n];
                        const f32x4 c = {ta[0], ta[2], tb[0], tb[2]}, s = {ta[1], ta[3], tb[1], tb[3]};
                        o1[n] = y1 * c - y2 * s; o2[n] = y2 * c + y1 * s;
                    }
                    const size_t off = (size_t)row * DA + head * 64 + 8 * fq;
                    if (isq) { *(v4u*)(dst + off) = pack8(o1[0] * QSCALE, o1[1] * QSCALE); *(v4u*)(dst + off + 32) = pack8(o2[0] * QSCALE, o2[1] * QSCALE); }
                    else { *(v4u*)(dst + off) = pack8(o1[0], o1[1]); *(v4u*)(dst + off + 32) = pack8(o2[0], o2[1]); }
                    if (wout) {
                        float* op = sample ? out + OUT_KNEW + (size_t)(row - MP) * DA : out + OUT_KWIN + ((size_t)(pm >> 4) * WIN + (256 * (pm & 15) + rit - (SEQ - WIN))) * DA;
                        op += head * 64 + 8 * fq;
                        *(f32x4*)(op) = o1[0]; *(f32x4*)(op + 4) = o1[1]; *(f32x4*)(op + 32) = o2[0]; *(f32x4*)(op + 36) = o2[1];
                    }
                }
        } else if (pn < 6) {
            const int head = 4 * (pn & 1) + wc;
            const bool wout = sample || (pm & 15) >= 8;
#pragma unroll
            for (int ai = 0; ai < 2; ++ai)
#pragma unroll
                for (int m = 0; m < 4; ++m) {
                    const int rit = 128 * ai + 64 * wr + 16 * m + fr, row = 256 * pm + rit;
                    const float rs = rstd[row];
                    const size_t off = (size_t)row * DA + head * 64 + 8 * fq;
                    const f32x4 a0 = acc[ai][0][m][0] * rs, a1 = acc[ai][0][m][1] * rs, b0 = acc[ai][1][m][0] * rs, b1 = acc[ai][1][m][1] * rs;
                    bf16* V = (bf16*)(ws + WS_V); *(v4u*)(V + off) = pack8(a0, a1); *(v4u*)(V + off + 32) = pack8(b0, b1);
                    if (wout) {
                        float* op = sample ? out + OUT_VNEW + (size_t)(row - MP) * DA : out + OUT_VWIN + ((size_t)(pm >> 4) * WIN + (256 * (pm & 15) + rit - (SEQ - WIN))) * DA;
                        op += head * 64 + 8 * fq;
                        *(f32x4*)(op) = a0; *(f32x4*)(op + 4) = a1; *(f32x4*)(op + 32) = b0; *(f32x4*)(op + 36) = b1;
                    }
                }
        } else if (pn < 8) {
            bf16* dst = (bf16*)(ws + (pn == 6 ? WS_QB : WS_KB)); const float sc = pn == 6 ? 0.125f : 1.0f;
#pragma unroll
            for (int ai = 0; ai < 2; ++ai)
#pragma unroll
                for (int m = 0; m < 4; ++m) {
                    const int row = 256 * pm + 128 * ai + 64 * wr + 16 * m + fr;
                    const float rs = rstd[row] * sc;
                    const size_t off = (size_t)row * 256 + wc * 64 + 8 * fq;
                    *(v4u*)(dst + off) = pack8(acc[ai][0][m][0] * rs, acc[ai][0][m][1] * rs); *(v4u*)(dst + off + 32) = pack8(acc[ai][1][m][0] * rs, acc[ai][1][m][1] * rs);
                }
        } else if (pn < 14) {
            bf16* dst = (bf16*)(ws + (pn < 10 ? WS_VB : (pn < 12 ? WS_GA : WS_GB))); const bool act = pn >= 10;
            const int cb = 256 * (pn & 1) + 32 * wc + 8 * fq;
#pragma unroll
            for (int ai = 0; ai < 2; ++ai)
#pragma unroll
                for (int m = 0; m < 4; ++m) {
                    const int row = 256 * pm + 128 * ai + 64 * wr + 16 * m + fr;
                    const float rs = rstd[row];
#pragma unroll
                    for (int bj = 0; bj < 2; ++bj) {
                        f32x4 a = acc[ai][bj][m][0] * rs, b = acc[ai][bj][m][1] * rs;
                        if (act) {
#pragma unroll
                            for (int j = 0; j < 4; ++j) { a[j] = silu_f(a[j]); b[j] = silu_f(b[j]); }
                        }
                        *(v4u*)(dst + (size_t)row * 512 + cb + 128 * bj) = pack8(a, b);
                    }
                }
        } else {
            const int cb = 32 * wc + 8 * fq;
            f32x4 bg[2][2];
#pragma unroll
            for (int bj = 0; bj < 2; ++bj)
#pragma unroll
                for (int n = 0; n < 2; ++n) bg[bj][n] = *(const f32x4*)(bgate + cb + 128 * bj + 4 * n);
#pragma unroll
            for (int ai = 0; ai < 2; ++ai)
#pragma unroll
                for (int m = 0; m < 4; ++m) {
                    const int row = 256 * pm + 128 * ai + 64 * wr + 16 * m + fr;
                    const float rs = rstd[row];
#pragma unroll
                    for (int bj = 0; bj < 2; ++bj)
#pragma unroll
                        for (int n = 0; n < 2; ++n) {
                            f32x4 z = acc[ai][bj][m][n] * rs + bg[bj][n], r;
#pragma unroll
                            for (int j = 0; j < 4; ++j) { const float az = fabsf(z[j]); r[j] = (fminf(z[j], 0.f) - __logf(1.0f + fast_exp(-az))) * (1.0f / 16.0f); }
                            *(f32x4*)((float*)(ws + WS_LOGA) + (size_t)row * 256 + cb + 128 * bj + 4 * n) = r;
                        }
                }
        }
    }
};
struct EpiOut {
    static constexpr bool PERM = true, AFTER_DRAIN = false;
    const float* xp; const float* xs; float* out;
    __device__ __forceinline__ void operator()(const f32x4 (&acc)[2][2][4][2], const pg8::Unit& u, int wr, int wc, int fr, int fq) const {
        const int pm = u.pm; const bool sample = pm >= (MP / 256);
        const float* xb = sample ? xs + (size_t)(pm - MP / 256) * 256 * DM : xp + (size_t)pm * 256 * DM;
        float* ob = sample ? out + OUT_YS + (size_t)(pm - MP / 256) * 256 * DM : out + OUT_YP + (size_t)pm * 256 * DM;
        const int cb = 256 * u.pn + 32 * wc + 8 * fq;
#pragma unroll
        for (int ai = 0; ai < 2; ++ai)
#pragma unroll
            for (int m = 0; m < 4; ++m) {
                const size_t ro = (size_t)(128 * ai + 64 * wr + 16 * m + fr) * DM + cb;
#pragma unroll
                for (int bj = 0; bj < 2; ++bj) {
                    const f32x4 x0 = *(const f32x4*)(xb + ro + 128 * bj), x1 = *(const f32x4*)(xb + ro + 128 * bj + 4);
                    *(f32x4*)(ob + ro + 128 * bj) = x0 + acc[ai][bj][m][0]; *(f32x4*)(ob + ro + 128 * bj + 4) = x1 + acc[ai][bj][m][1];
                }
            }
    }
};
#define XB_TMO      128
#define XB_XCNT(j)  (256  + 64 * (j))
#define XB_XSUB(j)  (1280 + 64 * (j))
#define XB_XGEN(j)  (2304 + 64 * (j))
#define XB_TOP      3328
#define XB_TOPGEN   3392
#define XCD_BAR_WORDS 3456
#define XB_SPIN_CAP (1u << 18)

__device__ __forceinline__ unsigned xb_ld(unsigned* p)              { return __hip_atomic_load(p, __ATOMIC_RELAXED, __HIP_MEMORY_SCOPE_AGENT); }
__device__ __forceinline__ unsigned xb_add(unsigned* p, unsigned v) { return __hip_atomic_fetch_add(p, v, __ATOMIC_RELAXED, __HIP_MEMORY_SCOPE_AGENT); }
__device__ __forceinline__ unsigned xb_xcc_id() { return (unsigned)__builtin_amdgcn_s_getreg((3 << 11) | 20) & 0xFu; }
#define XB_SPIN(cond, bar) do { unsigned _sp = 0; while (cond) { __builtin_amdgcn_s_sleep(1); \
    if ((++_sp & 255u) == 0u) { if (xb_ld(&(bar)[XB_TMO])) break; if (_sp > XB_SPIN_CAP) { atomicAdd(&(bar)[XB_TMO], 1u); break; } } } } while (0)

struct XcdBarrier {
    unsigned* bar; unsigned x;
    volatile LAS unsigned* st;
};

__device__ __forceinline__ XcdBarrier xcd_barrier_post(unsigned* bar, volatile LAS unsigned* st) {
    XcdBarrier b; b.bar = bar; b.x = xb_xcc_id(); b.st = st;
    if (threadIdx.x == 0) (void)xb_add(&bar[XB_XCNT(b.x)], 1u);
    return b;
}
__device__ __forceinline__ void xcd_barrier_complete(unsigned* bar, unsigned x, unsigned& nloc, unsigned& nx) {
    const unsigned G = gridDim.x * gridDim.y * gridDim.z;
    unsigned sum, cnt, mine, sp = 0u;
    for (;;) {
        sum = 0u; cnt = 0u; mine = 0u;
#pragma unroll
        for (unsigned j = 0; j < 16; ++j) { const unsigned c = xb_ld(&bar[XB_XCNT(j)]); sum += c; cnt += (c > 0u) ? 1u : 0u; mine = (j == x) ? c : mine; }
        if (sum == G) break;
        __builtin_amdgcn_s_sleep(1);
        if ((++sp & 255u) == 0u) { if (xb_ld(&bar[XB_TMO])) break; if (sp > XB_SPIN_CAP) { atomicAdd(&bar[XB_TMO], 1u); break; } }
    }
    nloc = mine > 0u ? mine : 1u; nx = cnt > 0u ? cnt : 1u;
}

__device__ __forceinline__ void xcd_barrier(const XcdBarrier& b) {
    asm volatile("s_waitcnt vmcnt(0)" ::: "memory");
    __syncthreads();
    if (threadIdx.x == 0) {
        unsigned* bar = b.bar;
        __builtin_amdgcn_s_waitcnt(0);
        unsigned nloc = b.st[0], nx = b.st[1];
        if (nloc == 0u) { xcd_barrier_complete(bar, b.x, nloc, nx); b.st[0] = nloc; b.st[1] = nx; }
        const unsigned old = xb_add(&bar[XB_XSUB(b.x)], 1u);
        const unsigned gen = old / nloc;
        if (old + 1u == (gen + 1u) * nloc) {
            __builtin_amdgcn_fence(__ATOMIC_RELEASE, "agent");
            asm volatile("s_waitcnt vmcnt(0)" ::: "memory");
            const unsigned og = xb_add(&bar[XB_TOP], 1u);
            const unsigned tg = og / nx;
            if (og + 1u == (tg + 1u) * nx) xb_add(&bar[XB_TOPGEN], 1u);
            else XB_SPIN(xb_ld(&bar[XB_TOPGEN]) == tg, bar);
            __builtin_amdgcn_fence(__ATOMIC_ACQUIRE, "agent");
            xb_add(&bar[XB_XGEN(b.x)], 1u);
            asm volatile("s_waitcnt vmcnt(0)" ::: "memory");
        } else {
            XB_SPIN(xb_ld(&bar[XB_XGEN(b.x)]) == gen, bar);
            __builtin_amdgcn_fence(__ATOMIC_ACQUIRE, "agent");
            asm volatile("s_waitcnt vmcnt(0)" ::: "memory");
        }
    }
    __syncthreads();
}
struct Args { const float* in[13]; float* out; unsigned char* ws; int ph_lo, ph_hi; };
struct Frame {
    LAS unsigned char* lds; volatile LAS unsigned* MISC; gu32* ctl;
    int tid, lane, wave, G;
    const float *xp, *xs, *cK, *cV, *sG, *normw, *win, *wgu, *bgate, *qnw, *knw, *gnw, *wout;
    float* out; unsigned char* ws;
};
#define WSP(T, off) ((T*)(F.ws + (off)))

__device__ __forceinline__ void p0_transpose_item(const float* W, int ldw, int srccol0, const float* kscale, bf16* WT, int K, int dstrow0, LAS float* scr, int k0, int lane) {
#pragma unroll 8
    for (int i = 0; i < 32; ++i) { const int kk = 2 * i + (lane >> 5); const float sc = kscale ? kscale[k0 + kk] : 1.0f; scr[kk * 33 + (lane & 31)] = W[(size_t)(k0 + kk) * ldw + srccol0 + (lane & 31)] * sc; }
    LDS_WAIT(); asm volatile("" ::: "memory");
    const int c = lane & 7;
#pragma unroll
    for (int j = 0; j < 4; ++j) { const int n = (lane >> 3) + 8 * j; const LAS float* s = scr + (8 * c) * 33 + n;
        v4u o; o.x = pk2(s[0 * 33], s[1 * 33]); o.y = pk2(s[2 * 33], s[3 * 33]); o.z = pk2(s[4 * 33], s[5 * 33]); o.w = pk2(s[6 * 33], s[7 * 33]);
        *(v4u*)(WT + (size_t)(dstrow0 + n) * K + k0 + 8 * c) = o; }
    LDS_WAIT(); asm volatile("" ::: "memory");
}
__device__ __forceinline__ int in_src_col(int n0) {
    const int pn = n0 >> 8, within = n0 & 255, bj = within >> 7, wc = (within & 127) >> 5;
    if (pn < 6) return 512 * (pn >> 1) + 64 * (4 * (pn & 1) + wc) + 32 * bj;
    if (pn == 6) return 1536 + 64 * wc + 32 * bj;
    if (pn == 7) return 1792 + 64 * wc + 32 * bj;
    if (pn < 10) return 2048 + 256 * (pn - 8) + within;
    if (pn < 12) return 2576 + 256 * (pn - 10) + within;
    return 3088 + 256 * (pn - 12) + within;
}
__device__ __forceinline__ void p0_prologue(Frame& F) {
    LAS float* scr = (LAS float*)(F.lds + RING_OFF + F.wave * 16384);
    const int gw = blockIdx.x * NWAVES + F.wave, NGW = F.G * NWAVES;
    bf16* WinT = WSP(bf16, WS_WIN); bf16* WoutT = WSP(bf16, WS_WOUT);
    constexpr int I_IN = 112 * 16, I_OUT = 32 * 16;
    for (int it = gw; it < I_IN + I_OUT; it += NGW) {
        if (it < I_IN) { const int ng = it >> 4, kb = it & 15; p0_transpose_item(F.win, 3600, in_src_col(32 * ng), F.normw, WinT, DM, 32 * ng, scr, 64 * kb, F.lane); }
        else { const int r = it - I_IN, ng = r >> 4, kb = r & 15; p0_transpose_item(F.wout, DM, 32 * ng, nullptr, WoutT, DM, 32 * ng, scr, 64 * kb, F.lane); }
    }
    const int gt = blockIdx.x * (NWAVES * 64) + F.tid, NGT = F.G * NWAVES * 64;
    for (int it = gt; it < 256 * 128; it += NGT) {
        const int c = it & 255, k8 = it >> 8; float r[8];
#pragma unroll
        for (int kk = 0; kk < 8; ++kk) { const int k = 8 * k8 + kk; const float* wr_ = F.win + (size_t)k * 3600 + 2560; float s = 0.f;
#pragma unroll
            for (int q = 0; q < RANK; ++q) s += wr_[q] * F.wgu[q * 256 + c];
            r[kk] = s * F.normw[k]; }
        v4u o; o.x = pk2(r[0], r[1]); o.y = pk2(r[2], r[3]); o.z = pk2(r[4], r[5]); o.w = pk2(r[6], r[7]);
        *(v4u*)(WinT + (size_t)(3584 + c) * DM + 8 * k8) = o;
    }
    float* rope = WSP(float, WS_ROPE);
    for (int it = gt; it < (SEQ + ST) * 32; it += NGT) {
        const int ri = it >> 5, d = it & 31; const float pos = (float)(ri < SEQ ? ri : PAST + (ri - SEQ));
        const float invf = exp2f(-(float)d * (13.287712379549449f / 32.0f));
        float s, c; sincosf(pos * invf, &s, &c);
        rope[2 * it] = c; rope[2 * it + 1] = s;
    }
    if (blockIdx.x == 0 && F.wave == 0) {
        const float mq = wave_max(fabsf(F.qnw[F.lane])), mk = wave_max(fabsf(F.knw[F.lane]));
        if (F.lane == 0) WSP(float, WS_SCAL)[0] = 8.0f * LOG2E * mq * mk;
        WSP(float, WS_SCAL)[64 + F.lane] = F.qnw[F.lane]; WSP(float, WS_SCAL)[128 + F.lane] = F.knw[F.lane];
    }
    bf16* XB = WSP(bf16, WS_XB); float* RS = WSP(float, WS_RSTD);
    for (int m = gw; m < MTOT; m += NGW) {
        const float* xrow = m < MP ? F.xp + (size_t)m * DM : F.xs + (size_t)(m - MP) * DM;
        const f32x4* xr = (const f32x4*)xrow + F.lane;
        f32x4 v[4]; float s = 0.f;
#pragma unroll
        for (int j = 0; j < 4; ++j) { v[j] = xr[64 * j]; s += (v[j][0] * v[j][0] + v[j][1] * v[j][1]) + (v[j][2] * v[j][2] + v[j][3] * v[j][3]); }
        s = wave_sum(s);
        if (F.lane == 0) RS[m] = 1.0f / sqrtf(s * (1.0f / DM) + EPS);
        v2u* o8 = (v2u*)(XB + (size_t)m * DM) + F.lane;
#pragma unroll
        for (int j = 0; j < 4; ++j) { v2u o; o.x = pk2(v[j][0], v[j][1]); o.y = pk2(v[j][2], v[j][3]); o8[64 * j] = o; }
    }
}
typedef short v4i16_t __attribute__((ext_vector_type(4)));
__device__ __forceinline__ s16x4 tr16(const LAS unsigned char* p) { return __builtin_bit_cast(s16x4, __builtin_amdgcn_ds_read_tr16_b64_v4i16((LAS v4i16_t*)p)); }
__device__ __forceinline__ bf16x8 cat8(s16x4 lo, s16x4 hi) { return (bf16x8){lo[0], lo[1], lo[2], lo[3], hi[0], hi[1], hi[2], hi[3]}; }
__device__ __forceinline__ bf16x8 pk8(f32x4 a, f32x4 b) { return __builtin_bit_cast(bf16x8, pack8(a, b)); }
#define MFMA16(a, b, c) __builtin_amdgcn_mfma_f32_16x16x32_bf16((a), (b), (c), 0, 0, 0)
#define MFMA32(a, b, c) __builtin_amdgcn_mfma_f32_32x32x16_bf16((a), (b), (c), 0, 0, 0)

constexpr int G_QT = 0, G_RP = 144, G_KT = 9216, G_V = 18432, G_VP = 288, G_P = 36864, G_O = 46080, G_OP = 528, G_TOT = 79872, G_D = 83968;
__device__ __forceinline__ void gla_prompt_item(Frame& F, int b, int h) {
    int tid = F.tid; asm volatile("" : "+v"(tid));
    const int lane = tid & 63, w = __builtin_amdgcn_readfirstlane(tid >> 6), g = lane >> 4, i16 = lane & 15;
    LAS unsigned char* L = F.lds + RING_OFF;
    const bf16* QBp = WSP(bf16, WS_QB); const bf16* KBp = WSP(bf16, WS_KB); const bf16* VBp = WSP(bf16, WS_VB); const bf16* GBp = WSP(bf16, WS_GB);
    const float* LOGA = WSP(float, WS_LOGA); bf16* MIX = WSP(bf16, WS_MIX);
    const size_t tokb = (size_t)b * SEQ;
    const int kp = tid & 31, seg = tid >> 5;
    const int et = tid >> 3, evc = tid & 7;
    f32x4 gw4[4];
#pragma unroll
    for (int q = 0; q < 4; ++q) gw4[q] = *(const f32x4*)(F.gnw + 16 * evc + 4 * q);
    f32x4 sacc[4];
#pragma unroll
    for (int kb = 0; kb < 4; ++kb) sacc[kb] = (f32x4){0.f, 0.f, 0.f, 0.f};
    f32x2 lg[4]; unsigned qv[4], kv[4]; v4u vv[2]; v4u gg[2];
#define GLA_LOAD(n) do { const size_t t0_ = tokb + 64 * (size_t)(n); \
        _Pragma("unroll") for (int i = 0; i < 4; ++i) { const size_t tk = t0_ + 4 * seg + i; lg[i] = *(const f32x2*)(LOGA + tk * 256 + h * 64 + 2 * kp); \
            qv[i] = *(const unsigned*)(QBp + tk * 256 + h * 64 + 2 * kp); kv[i] = *(const unsigned*)(KBp + tk * 256 + h * 64 + 2 * kp); } \
        _Pragma("unroll") for (int i = 0; i < 2; ++i) { const int p_ = tid + 512 * i, row_ = p_ >> 4, c_ = p_ & 15; vv[i] = *(const v4u*)(VBp + (t0_ + row_) * 512 + h * 128 + 8 * c_); } } while (0)
    GLA_LOAD(0);
    for (int n = 0; n < SEQ / 64; ++n) {
        const size_t t0 = tokb + 64 * (size_t)n;
        f32x2 cs[4]; cs[0] = lg[0];
#pragma unroll
        for (int i = 1; i < 4; ++i) cs[i] = cs[i - 1] + lg[i];
        *(LAS f32x2*)(L + G_TOT + (seg * 64 + 2 * kp) * 4) = cs[3];
#pragma unroll
        for (int i = 0; i < 2; ++i) { const int p_ = tid + 512 * i, row_ = p_ >> 4, c_ = p_ & 15; *(LAS v4u*)(L + G_V + row_ * G_VP + c_ * 16) = vv[i]; }
        LBAR();
        f32x2 pre = {0.f, 0.f}, tot = {0.f, 0.f};
#pragma unroll
        for (int s = 0; s < 16; ++s) { const f32x2 v = *(const LAS f32x2*)(L + G_TOT + (s * 64 + 2 * kp) * 4); if (s < seg) pre += v; tot += v; }
#pragma unroll
        for (int i = 0; i < 4; ++i) {
            f32x2 bb = pre + cs[i]; bb.x = fmaxf(bb.x, -80.f); bb.y = fmaxf(bb.y, -80.f);
            const float ep0 = fast_exp(bb.x), ep1 = fast_exp(bb.y), em0 = fast_exp(-bb.x), em1 = fast_exp(-bb.y);
            const int t = 4 * seg + i;
            *(LAS unsigned*)(L + G_QT + t * G_RP + kp * 4) = pk2(bflo(qv[i]) * ep0, bfhi(qv[i]) * ep1);
            *(LAS unsigned*)(L + G_KT + t * G_RP + kp * 4) = pk2(bflo(kv[i]) * em0, bfhi(kv[i]) * em1);
        }
        if (seg == 0) { f32x2 dd; dd.x = fast_exp(fmaxf(tot.x, -80.f)); dd.y = fast_exp(fmaxf(tot.y, -80.f)); *(LAS f32x2*)(L + G_D + 2 * kp * 4) = dd; }
#pragma unroll
        for (int i = 0; i < 2; ++i) gg[i] = *(const v4u*)(GBp + (t0 + et) * 512 + h * 128 + 16 * evc + 8 * i);
        if (n + 1 < SEQ / 64) GLA_LOAD(n + 1);
        LBAR();
        {
            const int tb = w >> 1;
#pragma unroll
            for (int q2 = 0; q2 < 2; ++q2) {
                const int sb = 2 * (w & 1) + q2;
                f32x4 c4 = {0.f, 0.f, 0.f, 0.f};
                if (sb <= tb) {
#pragma unroll
                    for (int sp = 0; sp < 2; ++sp) {
                        const bf16x8 a = *(const LAS bf16x8*)(L + G_KT + (16 * sb + i16) * G_RP + (32 * sp + 8 * g) * 2);
                        const bf16x8 bq = *(const LAS bf16x8*)(L + G_QT + (16 * tb + i16) * G_RP + (32 * sp + 8 * g) * 2);
                        c4 = MFMA16(a, bq, c4);
                    }
                }
                const int t = 16 * tb + i16, s0 = 16 * sb + 4 * g;
#pragma unroll
                for (int r = 0; r < 4; ++r) if (s0 + r > t) c4[r] = 0.f;
                v2u pk; pk.x = pk2(c4[0], c4[1]); pk.y = pk2(c4[2], c4[3]);
                *(LAS v2u*)(L + G_P + t * G_RP + s0 * 2) = pk;
            }
        }
        LBAR();
        {
            bf16x8 vf[2];
#pragma unroll
            for (int sp = 0; sp < 2; ++sp) { const LAS unsigned char* vp = L + G_V + (32 * sp + 8 * g + (i16 >> 2)) * G_VP + (16 * w + 4 * (i16 & 3)) * 2; vf[sp] = cat8(tr16(vp), tr16(vp + 4 * G_VP)); }
            f32x4 oacc[4];
#pragma unroll
            for (int tb = 0; tb < 4; ++tb) {
                oacc[tb] = (f32x4){0.f, 0.f, 0.f, 0.f};
#pragma unroll
                for (int sp = 0; sp < 2; ++sp) {
                    if (sp == 1 && tb < 2) continue;
                    const bf16x8 a = *(const LAS bf16x8*)(L + G_P + (16 * tb + i16) * G_RP + (32 * sp + 8 * g) * 2);
                    oacc[tb] = MFMA16(a, vf[sp], oacc[tb]);
                }
            }
            bf16x8 bs[2];
#pragma unroll
            for (int sp = 0; sp < 2; ++sp) bs[sp] = pk8(sacc[2 * sp], sacc[2 * sp + 1]);
#pragma unroll
            for (int tb = 0; tb < 4; ++tb)
#pragma unroll
                for (int sp = 0; sp < 2; ++sp) {
                    const v2u a0 = *(const LAS v2u*)(L + G_QT + (16 * tb + i16) * G_RP + (32 * sp + 4 * g) * 2);
                    const v2u a1 = *(const LAS v2u*)(L + G_QT + (16 * tb + i16) * G_RP + (32 * sp + 16 + 4 * g) * 2);
                    v4u aa; aa.x = a0.x; aa.y = a0.y; aa.z = a1.x; aa.w = a1.y;
                    oacc[tb] = MFMA16(__builtin_bit_cast(bf16x8, aa), bs[sp], oacc[tb]);
                }
#pragma unroll
            for (int kb = 0; kb < 4; ++kb) {
#pragma unroll
                for (int sp = 0; sp < 2; ++sp) { const LAS unsigned char* kq = L + G_KT + (32 * sp + 8 * g + (i16 >> 2)) * G_RP + (16 * kb + 4 * (i16 & 3)) * 2; sacc[kb] = MFMA16(cat8(tr16(kq), tr16(kq + 4 * G_RP)), vf[sp], sacc[kb]); }
                const f32x4 dv = *(const LAS f32x4*)(L + G_D + (16 * kb + 4 * g) * 4);
                sacc[kb] = sacc[kb] * dv;
            }
#pragma unroll
            for (int tb = 0; tb < 4; ++tb)
#pragma unroll
                for (int r = 0; r < 4; ++r) *(LAS float*)(L + G_O + (16 * tb + 4 * g + r) * G_OP + (16 * w + i16) * 4) = oacc[tb][r];
        }
        LBAR();
        {
            f32x4 o4[4]; float ss = 0.f;
#pragma unroll
            for (int q = 0; q < 4; ++q) { o4[q] = *(const LAS f32x4*)(L + G_O + et * G_OP + (16 * evc + 4 * q) * 4); ss += (o4[q][0] * o4[q][0] + o4[q][1] * o4[q][1]) + (o4[q][2] * o4[q][2] + o4[q][3] * o4[q][3]); }
            ss += __shfl_xor(ss, 1); ss += __shfl_xor(ss, 2); ss += __shfl_xor(ss, 4);
            const float rn = __builtin_amdgcn_rsqf(ss * (1.0f / 128.0f) + EPS);
#pragma unroll
            for (int i = 0; i < 2; ++i) {
                const f32x4 ga = {bflo(gg[i].x), bfhi(gg[i].x), bflo(gg[i].y), bfhi(gg[i].y)}, gb = {bflo(gg[i].z), bfhi(gg[i].z), bflo(gg[i].w), bfhi(gg[i].w)};
                const f32x4 ra = o4[2 * i] * rn * gw4[2 * i] * ga, rb = o4[2 * i + 1] * rn * gw4[2 * i + 1] * gb;
                *(v4u*)(MIX + (t0 + et) * DM + DA + h * 128 + 16 * evc + 8 * i) = pack8(ra, rb);
            }
        }
    }
#undef GLA_LOAD
    float* so = F.out + OUT_SP + ((size_t)(b * HB + h) * DKB) * DVB;
#pragma unroll
    for (int kb = 0; kb < 4; ++kb)
#pragma unroll
        for (int r = 0; r < 4; ++r) so[(size_t)(16 * kb + 4 * g + r) * DVB + 16 * w + i16] = sacc[kb][r];
    LBAR();
}

__device__ __forceinline__ void gla_sample_item(Frame& F, int b, int h) {
    int tid = F.tid; asm volatile("" : "+v"(tid));
    const int lane = tid & 63, w = __builtin_amdgcn_readfirstlane(tid >> 6);
    LAS float* LA = (LAS float*)(F.lds + RING_OFF);
    LAS float* LK = LA + 512; LAS float* LQ = LK + 512;
    LAS float* LV = LQ + 512;
    LAS float* LO = LV + 1024;
    const bf16* QBp = WSP(bf16, WS_QB); const bf16* KBp = WSP(bf16, WS_KB); const bf16* VBp = WSP(bf16, WS_VB); const bf16* GBp = WSP(bf16, WS_GB);
    const float* LOGA = WSP(float, WS_LOGA); bf16* MIX = WSP(bf16, WS_MIX);
    const size_t row0 = (size_t)MP + 8 * b;
    { const int t = tid >> 6, k = tid & 63; const size_t r = row0 + t;
      LA[tid] = fast_exp(LOGA[r * 256 + h * 64 + k]);
      LK[tid] = bflo((unsigned)KBp[r * 256 + h * 64 + k]); LQ[tid] = bflo((unsigned)QBp[r * 256 + h * 64 + k]);
#pragma unroll
      for (int i = 0; i < 2; ++i) { const int e = tid + 512 * i, tt = e >> 7, v = e & 127; LV[e] = bflo((unsigned)VBp[(row0 + tt) * 512 + h * 128 + v]); } }
    const int v = tid & 127, kq = tid >> 7;
    const float* sin_ = F.sG + ((size_t)(b * HB + h) * DKB + 16 * kq) * DVB + v;
    float S[16];
#pragma unroll
    for (int i = 0; i < 16; ++i) S[i] = sin_[(size_t)i * DVB];
    LBAR();
#pragma unroll
    for (int t = 0; t < 8; ++t) {
        const float vt = LV[t * 128 + v]; float po = 0.f;
#pragma unroll
        for (int i = 0; i < 16; ++i) { const int k = 16 * kq + i; S[i] = LA[t * 64 + k] * S[i] + LK[t * 64 + k] * vt; po += LQ[t * 64 + k] * S[i]; }
        LO[(t * 4 + kq) * 128 + v] = po;
    }
    float* sout = F.out + OUT_SS + ((size_t)(b * HB + h) * DKB + 16 * kq) * DVB + v;
#pragma unroll
    for (int i = 0; i < 16; ++i) sout[(size_t)i * DVB] = S[i];
    LBAR();
    { const int t = w, v2 = 2 * lane;
      float o0 = 0.f, o1 = 0.f;
#pragma unroll
      for (int q = 0; q < 4; ++q) { const f32x2 p = *(const LAS f32x2*)(LO + (t * 4 + q) * 128 + v2); o0 += p.x; o1 += p.y; }
      const float ss = wave_sum(o0 * o0 + o1 * o1);
      const float rn = __builtin_amdgcn_rsqf(ss * (1.0f / 128.0f) + EPS);
      const unsigned gt = *(const unsigned*)(GBp + (row0 + t) * 512 + h * 128 + v2);
      const f32x2 gw = *(const f32x2*)(F.gnw + v2);
      *(unsigned*)(MIX + (row0 + t) * DM + DA + h * 128 + v2) = pk2(o0 * rn * gw.x * bflo(gt), o1 * rn * gw.y * bfhi(gt)); }
    LBAR();
}

__device__ __forceinline__ void attn_sample_item(Frame& F, int b, int h) {
    int tid = F.tid; asm volatile("" : "+v"(tid));
    const int lane = tid & 63, t = __builtin_amdgcn_readfirstlane(tid >> 6), g4 = lane >> 4, c = lane & 15;
    const bf16* Qp = WSP(bf16, WS_Q); const bf16* GAp = WSP(bf16, WS_GA); bf16* MIX = WSP(bf16, WS_MIX);
    const float mref = WSP(const float, WS_SCAL)[0];
    const size_t row = (size_t)MP + 8 * b + t;
    const v2u qraw = *(const v2u*)(Qp + row * DA + h * 64 + 4 * c);
    const f32x4 q = {bflo(qraw.x), bfhi(qraw.x), bflo(qraw.y), bfhi(qraw.y)};
    const float* cK = F.cK + ((size_t)b * WIN * HA + h) * HD + 4 * c; const float* cV = F.cV + ((size_t)b * WIN * HA + h) * HD + 4 * c;
    const float* nK = F.out + OUT_KNEW + ((size_t)b * ST * HA + h) * HD + 4 * c; const float* nV = F.out + OUT_VNEW + ((size_t)b * ST * HA + h) * HD + 4 * c;
    f32x4 o = {0.f, 0.f, 0.f, 0.f}; float l = 0.f;
#pragma unroll
    for (int di = 0; di < 3; ++di) {
        const int D = di == 0 ? 16 : (di == 1 ? 4 : 1);
#pragma unroll 1
        for (int it0 = 0; it0 < 32; it0 += 4) {
            f32x4 kv[4], vv[4];
#pragma unroll
            for (int u = 0; u < 4; ++u) {
                const int j = 4 * (it0 + u) + g4;
                const int idx = WIN + t - D * j;
                const bool fresh = idx >= WIN;
                const float* kp = fresh ? nK + (size_t)(idx - WIN) * (HA * HD) : cK + (size_t)idx * (HA * HD);
                const float* vp = fresh ? nV + (size_t)(idx - WIN) * (HA * HD) : cV + (size_t)idx * (HA * HD);
                kv[u] = *(const f32x4*)kp; vv[u] = *(const f32x4*)vp;
            }
#pragma unroll
            for (int u = 0; u < 4; ++u) {
                float d = (kv[u][0] * q[0] + kv[u][1] * q[1]) + (kv[u][2] * q[2] + kv[u][3] * q[3]);
                d += __shfl_xor(d, 1); d += __shfl_xor(d, 2); d += __shfl_xor(d, 4); d += __shfl_xor(d, 8);
                const float p = fast_exp2(d - mref);
                l += p; o += vv[u] * p;
            }
        }
        {
            const int idx = WIN + t - D * 128;
            const f32x4 kv = *(const f32x4*)(cK + (size_t)idx * (HA * HD)), vv = *(const f32x4*)(cV + (size_t)idx * (HA * HD));
            float d = (kv[0] * q[0] + kv[1] * q[1]) + (kv[2] * q[2] + kv[3] * q[3]);
            d += __shfl_xor(d, 1); d += __shfl_xor(d, 2); d += __shfl_xor(d, 4); d += __shfl_xor(d, 8);
            const float p = g4 == 0 ? fast_exp2(d - mref) : 0.f;
            l += p; o += vv * p;
        }
    }
#pragma unroll
    for (int j = 0; j < 4; ++j) { o[j] += __shfl_xor(o[j], 16); o[j] += __shfl_xor(o[j], 32); }
    l += __shfl_xor(l, 16); l += __shfl_xor(l, 32);
    if (g4 == 0) {
        const float rl = 1.0f / l;
        const v2u gr = *(const v2u*)(GAp + row * DA + h * 64 + 4 * c);
        v2u w_; w_.x = pk2(o[0] * rl * bflo(gr.x), o[1] * rl * bfhi(gr.x)); w_.y = pk2(o[2] * rl * bflo(gr.y), o[3] * rl * bfhi(gr.y));
        *(v2u*)(MIX + row * DM + h * 64 + 4 * c) = w_;
    }
}
constexpr int A_K = 0, A_V = 65536;
constexpr int N_GLAP = NB * HB, N_ATTS = SB * HA, N_GLAS = SB * HB, N_ATTP = NB * 4 * 96;
constexpr int T_ATTS = N_GLAP, T_GLAS = T_ATTS + N_ATTS, T_ATTP = T_GLAS + N_GLAS, T_TOTAL = T_ATTP + N_ATTP;
struct AttItem { int b, hp, g, D, r, m0; };
__device__ __forceinline__ AttItem att_decode(int idx) {
    AttItem a; const int bhp = idx / 96, rem = idx - bhp * 96; a.b = bhp >> 2; a.hp = bhp & 3; a.g = rem >> 5; const int blk = rem & 31;
    a.D = a.g == 0 ? 16 : (a.g == 1 ? 4 : 1); const int sh = a.g == 0 ? 1 : (a.g == 1 ? 3 : 5);
    a.r = blk >> sh; a.m0 = (blk & ((1 << sh) - 1)) * 128; return a;
}
__device__ __forceinline__ void att_dma_k(Frame& F, const AttItem& a, int w, int lane) {
    const bf16* Kp = WSP(bf16, WS_K);
#pragma unroll
    for (int e = 0; e < 8; ++e) {
        const int ii = 8 * w + e, head = ii >> 5, chunk = (ii >> 2) & 7, kg = ii & 3;
        if (a.m0 == 0 && kg < 2) continue;
        const int m = a.m0 - 128 + 64 * kg + lane; const size_t row = (size_t)a.b * SEQ + (size_t)m * a.D + a.r;
        __builtin_amdgcn_global_load_lds((const unsigned*)(Kp + row * DA + (2 * a.hp + head) * 64 + chunk * 8), (LAS unsigned*)(F.lds + RING_OFF + A_K + head * 32768 + chunk * 4096 + kg * 1024), 16, 0, 0);
    }
}
__device__ __forceinline__ void att_dma_v(Frame& F, const AttItem& a, int w, int lane) {
    const bf16* Vp = WSP(bf16, WS_V);
#pragma unroll
    for (int e = 0; e < 8; ++e) {
        const int ii = 8 * w + e, head = ii >> 5, dh = (ii >> 4) & 1, kg = ii & 15;
        if (a.m0 == 0 && kg < 8) continue;
        const int m = a.m0 - 128 + 16 * kg + (lane >> 2); const size_t row = (size_t)a.b * SEQ + (size_t)m * a.D + a.r;
        __builtin_amdgcn_global_load_lds((const unsigned*)(Vp + row * DA + (2 * a.hp + head) * 64 + dh * 32 + (lane & 3) * 8), (LAS unsigned*)(F.lds + RING_OFF + A_V + head * 32768 + dh * 16384 + kg * 1024), 16, 0, 0);
    }
}
__device__ __forceinline__ int crow(int r, int hi) { return (r & 3) + 8 * (r >> 2) + 4 * hi; }
__device__ __forceinline__ void attn_prompt_loop(Frame& F, int t) {
    int tid_ = F.tid; asm volatile("" : "+v"(tid_));
    const int lane = tid_ & 63, w = __builtin_amdgcn_readfirstlane(tid_ >> 6), r32 = lane & 31, hi = lane >> 5, hh = w >> 2, qs = w & 3;
    const bf16* Qp = WSP(bf16, WS_Q); bf16* OP = WSP(bf16, WS_OPART); float* LP = WSP(float, WS_LPART);
    const float mref = WSP(const float, WS_SCAL)[0];
    const LAS unsigned char* L = F.lds + RING_OFF;
    AttItem a = att_decode(t - T_ATTP);
    att_dma_k(F, a, w, lane);
    for (;;) {
        VM_WAIT(); LBAR();
        if (tid_ == 0) F.MISC[4] = __hip_atomic_fetch_add(F.ctl + CW_TICKET, 1u, RLX_AGENT);
        const int mq = a.m0 + 32 * qs + r32; const size_t qrow = (size_t)a.b * SEQ + (size_t)mq * a.D + a.r; const int head = 2 * a.hp + hh;
        bf16x8 qf[4];
#pragma unroll
        for (int d0 = 0; d0 < 4; ++d0) qf[d0] = *(const bf16x8*)(Qp + qrow * DA + head * 64 + 16 * d0 + 8 * hi);
        att_dma_v(F, a, w, lane);
        const int jjs = a.m0 == 0 ? 4 - qs : 0;
        v4u pw[5][2]; float lsum = 0.f;
#pragma unroll
        for (int jj = 0; jj < 5; ++jj) {
            if (jj >= jjs) {
                const int kk0 = 32 * (qs + jj);
                f32x16 s;
#pragma unroll
                for (int r = 0; r < 16; ++r) s[r] = -mref;
#pragma unroll
                for (int d0 = 0; d0 < 4; ++d0) { const bf16x8 kf = *(const LAS bf16x8*)(L + A_K + hh * 32768 + (2 * d0 + hi) * 4096 + (kk0 + r32) * 16); s = MFMA32(kf, qf[d0], s); }
#pragma unroll
                for (int r = 0; r < 16; ++r) {
                    float p = fast_exp2(s[r]);
                    if (jj == 0) { if (crow(r, hi) < r32) p = 0.f; }
                    if (jj == 4) { if (crow(r, hi) > r32) p = 0.f; }
                    s[r] = p; lsum += p;
                }
#pragma unroll
                for (int k2 = 0; k2 < 2; ++k2) { v4u x; x.x = pk2(s[8 * k2 + 0], s[8 * k2 + 1]); x.y = pk2(s[8 * k2 + 2], s[8 * k2 + 3]); x.z = pk2(s[8 * k2 + 4], s[8 * k2 + 5]); x.w = pk2(s[8 * k2 + 6], s[8 * k2 + 7]); pw[jj][k2] = x; }
            } else { pw[jj][0] = (v4u){0u, 0u, 0u, 0u}; pw[jj][1] = (v4u){0u, 0u, 0u, 0u}; }
        }
        VM_WAIT(); LBAR();
        const int tn = __builtin_amdgcn_readfirstlane((int)F.MISC[4]);
        AttItem an = a;
        if (tn < T_TOTAL) { an = att_decode(tn - T_ATTP); att_dma_k(F, an, w, lane); }
        f32x16 o[2];
#pragma unroll
        for (int r = 0; r < 16; ++r) { o[0][r] = 0.f; o[1][r] = 0.f; }
        const LAS unsigned char* vb = L + A_V + hh * 32768 + ((lane >> 4) & 1) * 32 + (lane & 3) * 8 + (4 * hi + ((lane & 15) >> 2)) * 64;
#pragma unroll
        for (int jj = 0; jj < 5; ++jj) {
            if (jj >= jjs) {
                const int kk0 = 32 * (qs + jj);
#pragma unroll
                for (int k2 = 0; k2 < 2; ++k2)
#pragma unroll
                    for (int dh = 0; dh < 2; ++dh) {
                        const LAS unsigned char* vp = vb + dh * 16384 + (kk0 + 16 * k2) * 64;
                        o[dh] = MFMA32(cat8(tr16(vp), tr16(vp + 512)), __builtin_bit_cast(bf16x8, pw[jj][k2]), o[dh]);
                    }
            }
        }
        bf16* orow = OP + (size_t)a.g * OPART_STRIDE + qrow * DA + head * 64 + 4 * hi;
#pragma unroll
        for (int dh = 0; dh < 2; ++dh)
#pragma unroll
            for (int u = 0; u < 4; ++u) { v2u x; x.x = pk2(o[dh][4 * u], o[dh][4 * u + 1]); x.y = pk2(o[dh][4 * u + 2], o[dh][4 * u + 3]); *(v2u*)(orow + 32 * dh + 8 * u) = x; }
        lsum += __shfl_xor(lsum, 32);
        if (hi == 0) LP[(size_t)a.g * LPART_STRIDE + qrow * HA + head] = lsum;
        if (tn >= T_TOTAL) break;
        a = an;
    }
    VM_WAIT(); LBAR();
}
__device__ __forceinline__ int p2_fetch(Frame& F) {
    if (F.tid == 0) F.MISC[4] = __hip_atomic_fetch_add(F.ctl + CW_TICKET, 1u, RLX_AGENT);
    LBAR(); const int t = __builtin_amdgcn_readfirstlane((int)F.MISC[4]); LBAR(); return t;
}
__device__ __forceinline__ void p2_phase(Frame& F) {
    int t = p2_fetch(F);
    while (t < T_TOTAL) {
#ifndef ONLY_ITEM
#define ONLY_ITEM -1
#endif
        if (t < T_ATTS) { if (ONLY_ITEM < 0 || ONLY_ITEM == 0) gla_prompt_item(F, t >> 2, t & 3); }
        else if (t < T_GLAS) { const int i = t - T_ATTS; if (ONLY_ITEM < 0 || ONLY_ITEM == 1) attn_sample_item(F, i >> 3, i & 7); }
        else if (t < T_ATTP) { const int i = t - T_GLAS; if (ONLY_ITEM < 0 || ONLY_ITEM == 2) gla_sample_item(F, i >> 2, i & 3); }
        else { if (ONLY_ITEM < 0 || ONLY_ITEM == 3) attn_prompt_loop(F, t); break; }
        t = p2_fetch(F);
    }
}
__device__ __forceinline__ void p2b_combine(Frame& F) {
    const bf16* OP = WSP(bf16, WS_OPART); const float* LP = WSP(float, WS_LPART); const bf16* GAp = WSP(bf16, WS_GA); bf16* MIX = WSP(bf16, WS_MIX);
    const size_t gt = (size_t)blockIdx.x * (NWAVES * 64) + F.tid, NGT = (size_t)F.G * NWAVES * 64;
    for (size_t it = gt; it < (size_t)MP * 64; it += NGT) {
        const size_t tok = it >> 6; const int c8 = (int)(it & 63), head = c8 >> 3;
        f32x4 a = {0.f, 0.f, 0.f, 0.f}, b = {0.f, 0.f, 0.f, 0.f}; float l = 0.f;
#pragma unroll
        for (int g = 0; g < 3; ++g) {
            const v4u x = *(const v4u*)(OP + (size_t)g * OPART_STRIDE + tok * DA + 8 * c8);
            a += (f32x4){bflo(x.x), bfhi(x.x), bflo(x.y), bfhi(x.y)}; b += (f32x4){bflo(x.z), bfhi(x.z), bflo(x.w), bfhi(x.w)};
            l += LP[(size_t)g * LPART_STRIDE + tok * HA + head];
        }
        const float rl = 1.0f / l;
        const v4u gx = *(const v4u*)(GAp + tok * DA + 8 * c8);
        a = a * rl * (f32x4){bflo(gx.x), bfhi(gx.x), bflo(gx.y), bfhi(gx.y)}; b = b * rl * (f32x4){bflo(gx.z), bfhi(gx.z), bflo(gx.w), bfhi(gx.w)};
        *(v4u*)(MIX + tok * DM + 8 * c8) = pack8(a, b);
    }
}

#ifndef MK_N_LAUNCHES
#define MK_N_LAUNCHES 5
#endif
constexpr int N_PHASES = 5;
__global__ void __launch_bounds__(NWAVES * 64, 2) hymba_fwd(Args args) {
    extern __shared__ __attribute__((aligned(16))) unsigned char lds[];
    Frame F;
    F.lds = (LAS unsigned char*)lds; F.MISC = (volatile LAS unsigned*)(F.lds + MISC_OFF);
    F.tid = threadIdx.x; F.lane = F.tid & 63; F.wave = __builtin_amdgcn_readfirstlane(F.tid >> 6); F.G = gridDim.x;
    F.ws = args.ws; F.ctl = (gu32*)(args.ws + WS_CTL); F.out = args.out;
    F.xp = args.in[0]; F.xs = args.in[1]; F.cK = args.in[2]; F.cV = args.in[3]; F.sG = args.in[4]; F.normw = args.in[5]; F.win = args.in[6]; F.wgu = args.in[7];
    F.bgate = args.in[8]; F.qnw = args.in[9]; F.knw = args.in[10]; F.gnw = args.in[11]; F.wout = args.in[12];
    for (int u = F.tid; u < (LDS_BYTES - LDSCTL_OFF) / 4; u += NWAVES * 64) ((LAS unsigned*)(F.lds + LDSCTL_OFF))[u] = 0u;
    __syncthreads();
    const int lo = args.ph_lo, hi = args.ph_hi;
    XcdBarrier bar; bar.bar = (unsigned*)(F.ctl + CW_BAR); bar.x = 0; bar.st = nullptr;
    if (hi - lo > 1) bar = xcd_barrier_post((unsigned*)(F.ctl + CW_BAR), F.MISC + 8);
#ifdef ONLY_PHASE
#define IN(k) ((k) == ONLY_PHASE && lo <= (k) && (k) < hi)
#else
#define IN(k) (lo <= (k) && (k) < hi)
#endif
#define BOTH(k) (IN(k) && IN((k) + 1))
    if (IN(0)) { p0_prologue(F); if (BOTH(0)) xcd_barrier(bar); }
    if (IN(1)) {
        pg8::Gemm g{WSP(const pg8::bf16_t, WS_XB), WSP(const pg8::bf16_t, WS_WIN), MTOT, NIN, DM}; pg8::StaticOrder S; S.init(MTOT, NIN, F.G, (int)blockIdx.x);
        EpiIn E{WSP(const float, WS_RSTD), WSP(const float, WS_ROPE), WSP(const float, WS_SCAL) + 64, F.bgate, F.ws, F.out};
        pg8::gemm_phase<EpiIn, pg8::StaticOrder, true, true>(F.lds + RING_OFF, g, S, E);
        if (BOTH(1)) xcd_barrier(bar);
    }
    if (IN(2)) { p2_phase(F); if (BOTH(2)) xcd_barrier(bar); }
    if (IN(3)) { p2b_combine(F); if (BOTH(3)) xcd_barrier(bar); }
    if (IN(4)) {
        pg8::Gemm g{WSP(const pg8::bf16_t, WS_MIX), WSP(const pg8::bf16_t, WS_WOUT), MTOT, DM, DM}; pg8::StaticOrder S; S.init(MTOT, DM, F.G, (int)blockIdx.x);
        EpiOut E{F.xp, F.xs, F.out};
        pg8::gemm_phase<EpiOut, pg8::StaticOrder, true, true>(F.lds + RING_OFF, g, S, E);
    }
#undef IN
#undef BOTH
}

extern "C" void kernel_launch(void* const* d_in, const int* in_sizes, int n_in, void* d_out, int out_size, void* d_ws, size_t ws_size, hipStream_t stream) {
    static int grid = 0;
    if (grid == 0) {
        if (n_in != 13 || (size_t)out_size != OUT_END || ws_size < WS_END) { fprintf(stderr, "kernel_launch: unexpected shapes (n_in %d out %d ws %zu)\n", n_in, out_size, ws_size); grid = -1; return; }
        int dev = 0, cus = 0, per_cu = 0;
        if (hipGetDevice(&dev) != hipSuccess || hipDeviceGetAttribute(&cus, hipDeviceAttributeMultiprocessorCount, dev) != hipSuccess) { grid = -1; return; }
        if (hipFuncSetAttribute((const void*)hymba_fwd, hipFuncAttributeMaxDynamicSharedMemorySize, LDS_BYTES) != hipSuccess) { fprintf(stderr, "kernel_launch: hipFuncSetAttribute failed\n"); grid = -1; return; }
        if (hipOccupancyMaxActiveBlocksPerMultiprocessor(&per_cu, (const void*)hymba_fwd, NWAVES * 64, LDS_BYTES) != hipSuccess || per_cu < 1) fprintf(stderr, "kernel_launch: occupancy query reports %d\n", per_cu);
        (void)hipGetLastError();
        grid = cus;
    }
    if (grid < 0) return;
    if (hipMemsetAsync((char*)d_ws + WS_CTL, 0, CTL_ZERO_BYTES, stream) != hipSuccess) return;
    Args a{};
    for (int i = 0; i < 13; ++i) a.in[i] = (const float*)d_in[i];
    a.out = (float*)d_out; a.ws = (unsigned char*)d_ws;
    constexpr int NL = MK_N_LAUNCHES;
    static_assert(NL == 1 || NL == N_PHASES, "MK_N_LAUNCHES is 1 or 5");
    for (int li = 0; li < NL; ++li) {
        a.ph_lo = (NL == 1) ? 0 : li; a.ph_hi = (NL == 1) ? N_PHASES : li + 1;
        hipLaunchKernelGGL(hymba_fwd, dim3(grid), dim3(NWAVES * 64), LDS_BYTES, stream, a);
        const hipError_t le = hipPeekAtLastError();
        if (le != hipSuccess) { fprintf(stderr, "kernel_launch: launch %d failed: %s\n", li, hipGetErrorName(le)); break; }
    }
}
```

```cpp
#include <hip/hip_runtime.h>
#include <cstdio>
#include <cstdint>
#include <cmath>
#define MK_N_LAUNCHES 1
namespace pg8 {
#define PG8_LAS __attribute__((address_space(3)))
typedef unsigned short bf16_t;
typedef short bf16x8 __attribute__((ext_vector_type(8)));
typedef float f32x4 __attribute__((ext_vector_type(4)));
typedef unsigned u32x4 __attribute__((ext_vector_type(4)));
constexpr int BM = 256, BK = 64, HALF = 128, HTB = HALF * BK * 2  , STAGE_BYTES = 8 * HTB, NXCD = 8, WGM = 8;

__host__ __device__ __forceinline__ int lds_byte(int r, int c) { const int st = (r >> 4) * 2 + (c >> 5), rr = r & 15, cc = c & 31, ob = rr * 64 + cc * 2; return st * 1024 + (ob ^ (((ob >> 9) & 1) << 5)); }
__host__ __device__ __forceinline__ void stage_rc(int b, int& R, int& C) { const int st = b / 1024, sb = b % 1024, swz = sb ^ (((sb >> 9) & 1) << 5); R = (st >> 1) * 16 + swz / 64; C = (st & 1) * 32 + (swz % 64) / 2; }
__host__ __device__ __forceinline__ int perm32(int rho) { const int n = rho >> 4, i = rho & 15; return 8 * (i >> 2) + 4 * n + (i & 3); }

struct Unit { int pm, pn; };
struct Gemm { const bf16_t* A; const bf16_t* Bt; int M, N, K; };

struct StaticOrder {
    int nM, nN, nwg, G, c;
    __host__ __device__ void init(int M, int N, int G_, int c_) { nM = M / BM; nN = N / BM; nwg = nM * nN; G = G_; c = c_; }
    __host__ __device__ bool next(int i, Unit& u) const {
        const long L = (long)i * G + c; if (L >= nwg) return false;
        int wgid = (int)L; { const int q = nwg / NXCD, r = nwg % NXCD, xcd = wgid % NXCD, off = wgid / NXCD; wgid = (xcd < r ? xcd * (q + 1) : r * (q + 1) + (xcd - r) * q) + off; }
        const int nig = WGM * nN, gid = wgid / nig, fm = gid * WGM, gsz = (nM - fm) < WGM ? (nM - fm) : WGM;
        u.pm = fm + ((wgid % nig) % gsz); u.pn = (wgid % nig) / gsz; return true;
    }
    __device__ __forceinline__ void a_ready(const Unit&) const {}
    __device__ __forceinline__ void done(const Unit&) const {}
};

__device__ __forceinline__ unsigned cvt_pk_bf16(float lo, float hi) { unsigned r; asm volatile("v_cvt_pk_bf16_f32 %0, %1, %2" : "=v"(r) : "v"(lo), "v"(hi)); return r; }
template <class Epi, class Sched, bool ALIGN_EPI = false, bool SP2 = false>
__device__ __forceinline__ void gemm_phase(PG8_LAS unsigned char* lds, const Gemm g, const Sched& S, const Epi& E) {
    const int tid = threadIdx.x, wid = __builtin_amdgcn_readfirstlane(tid >> 6), lane = tid & 63, wr = wid >> 2, wc = wid & 3, fr = lane & 15, fq = lane >> 4;
    const int K = g.K, nt = K / BK;
    unsigned voffA[2], voffB[2];
#pragma unroll
    for (int i = 0; i < 2; ++i) { int R, C; stage_rc(tid * 16 + i * 8192, R, C); const int Rb = Epi::PERM ? ((R & ~31) + perm32(R & 31)) : R;
        voffA[i] = (unsigned)(R * K + C) * 2u; voffB[i] = (unsigned)(Rb * K + C) * 2u; }
    const size_t kstep = (size_t)(BK * 2);
    const size_t hstep = (size_t)HALF * K * 2;
    const size_t tstep = 2 * hstep;
    const unsigned ldsw = (unsigned)wid * 1024u;
    const int aoff = lds_byte(wr * 64 + fr, fq * 8), boff = lds_byte(wc * 32 + fr, fq * 8);
#define PG8_SA(b, h) (((b) * 2 + (h)) * HTB)
#define PG8_SB(b, h) ((4 + (b) * 2 + (h)) * HTB)
#define PG8_STAGE(bufoff, gbase, voff) do { _Pragma("unroll") for (int _i = 0; _i < 2; ++_i) \
        __builtin_amdgcn_global_load_lds((const unsigned*)((const char*)(gbase) + (voff)[_i]), (PG8_LAS unsigned*)(lds + (bufoff) + ldsw + _i * 8192), 16, 0, 0); } while (0)
#define PG8_LDA(dst, b, h) do { _Pragma("unroll") for (int m = 0; m < 4; ++m) _Pragma("unroll") for (int k = 0; k < 2; ++k) dst[m][k] = *(const PG8_LAS bf16x8*)(lds + PG8_SA(b, h) + aoff + m * 2048 + k * 1024); } while (0)
#define PG8_LDB(dst, b, h) do { _Pragma("unroll") for (int n = 0; n < 2; ++n) _Pragma("unroll") for (int k = 0; k < 2; ++k) dst[n][k] = *(const PG8_LAS bf16x8*)(lds + PG8_SB(b, h) + boff + n * 2048 + k * 1024); } while (0)
#define PG8_MMA(ai, bj, At, Bt) do { __builtin_amdgcn_s_setprio(1); _Pragma("unroll") for (int m = 0; m < 4; ++m) _Pragma("unroll") for (int n = 0; n < 2; ++n) _Pragma("unroll") for (int k = 0; k < 2; ++k) \
        acc[ai][bj][m][n] = __builtin_amdgcn_mfma_f32_16x16x32_bf16(Bt[n][k], At[m][k], acc[ai][bj][m][n], 0, 0, 0); __builtin_amdgcn_s_setprio(0); } while (0)
#define PG8_WAIT_V(n) asm volatile("s_waitcnt vmcnt(" #n ")" ::: "memory")
#define PG8_WAIT_L(n) asm volatile("s_waitcnt lgkmcnt(" #n ")" ::: "memory")
#define PG8_BAR __builtin_amdgcn_s_barrier()
#define PG8_SCHED __builtin_amdgcn_sched_barrier(0)
    Unit cur, nxt; int ui = 0;
    if (!S.next(0, cur)) return;
    f32x4 acc[2][2][4][2];
#pragma unroll
    for (int a = 0; a < 2; ++a)
#pragma unroll
        for (int b = 0; b < 2; ++b)
#pragma unroll
            for (int m = 0; m < 4; ++m)
#pragma unroll
                for (int n = 0; n < 2; ++n) acc[a][b][m][n] = (f32x4){0.f, 0.f, 0.f, 0.f};
    bf16x8 At[4][2], B0[2][2], B1[2][2];
    const char* cA = (const char*)g.A + (size_t)cur.pm * tstep; const char* cB = (const char*)g.Bt + (size_t)cur.pn * tstep;
    S.a_ready(cur);
    if constexpr (SP2) {
        PG8_STAGE(PG8_SB(0, 0), cB, voffB); PG8_STAGE(PG8_SB(0, 1), cB + hstep, voffB); PG8_STAGE(PG8_SA(0, 0), cA, voffA); PG8_STAGE(PG8_SA(0, 1), cA + hstep, voffA);
        if (wr == 1) PG8_BAR;
        PG8_WAIT_V(2); PG8_BAR;
        PG8_STAGE(PG8_SB(1, 0), cB + kstep, voffB); PG8_STAGE(PG8_SA(1, 0), cA + kstep, voffA); PG8_STAGE(PG8_SB(1, 1), cB + hstep + kstep, voffB);
        PG8_WAIT_V(6); PG8_BAR;
    } else {
        PG8_STAGE(PG8_SB(0, 0), cB, voffB); PG8_STAGE(PG8_SA(0, 0), cA, voffA); PG8_STAGE(PG8_SB(0, 1), cB + hstep, voffB); PG8_STAGE(PG8_SA(0, 1), cA + hstep, voffA);
        if (wr == 1) PG8_BAR;
        PG8_WAIT_V(4); PG8_BAR;
        PG8_STAGE(PG8_SB(1, 0), cB + kstep, voffB); PG8_STAGE(PG8_SA(1, 0), cA + kstep, voffA); PG8_STAGE(PG8_SB(1, 1), cB + hstep + kstep, voffB);
        PG8_WAIT_V(6); PG8_BAR;
    }
    for (;;) {
        const bool has_next = S.next(ui + 1, nxt);
        const char* nA = has_next ? (const char*)g.A + (size_t)nxt.pm * tstep : cA; const char* nB = has_next ? (const char*)g.Bt + (size_t)nxt.pn * tstep : cB;
        for (int t = 0; t < nt; t += 2) {
            const bool last = (t == nt - 2);
            const char* a1 = cA + (size_t)(t + 1) * kstep;
            const char* a2 = last ? nA : cA + (size_t)(t + 2) * kstep; const char* b2 = last ? nB : cB + (size_t)(t + 2) * kstep;
            const char* a3 = a2 + kstep; const char* b3 = b2 + kstep;
            if (last && has_next) S.a_ready(nxt);
            if constexpr (SP2) {
            PG8_LDB(B0, 0, 0); PG8_LDB(B1, 0, 1); PG8_SCHED; PG8_LDA(At, 0, 0); PG8_STAGE(PG8_SA(1, 1), a1 + hstep, voffA);
            PG8_WAIT_V(8); PG8_WAIT_L(0); PG8_BAR; PG8_MMA(0, 0, At, B0); PG8_MMA(0, 1, At, B1); PG8_BAR; PG8_SCHED;
            PG8_LDA(At, 0, 1); PG8_STAGE(PG8_SB(0, 0), b2, voffB); PG8_STAGE(PG8_SB(0, 1), b2 + hstep, voffB); PG8_STAGE(PG8_SA(0, 0), a2, voffA);
            PG8_WAIT_V(8); PG8_WAIT_L(0); PG8_BAR; PG8_MMA(1, 0, At, B0); PG8_MMA(1, 1, At, B1); PG8_BAR; PG8_SCHED;
            PG8_LDB(B0, 1, 0); PG8_LDB(B1, 1, 1); PG8_SCHED; PG8_LDA(At, 1, 0); PG8_STAGE(PG8_SA(0, 1), a2 + hstep, voffA);
            PG8_WAIT_V(8); PG8_WAIT_L(0); PG8_BAR; PG8_MMA(0, 0, At, B0); PG8_MMA(0, 1, At, B1); PG8_BAR; PG8_SCHED;
            PG8_LDA(At, 1, 1); PG8_STAGE(PG8_SB(1, 0), b3, voffB); PG8_STAGE(PG8_SB(1, 1), b3 + hstep, voffB); PG8_STAGE(PG8_SA(1, 0), a3, voffA);
            PG8_WAIT_V(8); PG8_WAIT_L(0); PG8_BAR; PG8_MMA(1, 0, At, B0); PG8_MMA(1, 1, At, B1); PG8_BAR; PG8_SCHED;
            } else {
            PG8_LDB(B0, 0, 0); PG8_SCHED; PG8_LDA(At, 0, 0); PG8_STAGE(PG8_SA(1, 1), a1 + hstep, voffA);
            PG8_WAIT_L(8); PG8_BAR; PG8_WAIT_L(0); PG8_MMA(0, 0, At, B0); PG8_BAR; PG8_SCHED;
            PG8_LDB(B1, 0, 1); PG8_STAGE(PG8_SB(0, 0), b2, voffB);
            PG8_BAR; PG8_WAIT_L(0); PG8_MMA(0, 1, At, B1); PG8_BAR;
            PG8_LDA(At, 0, 1); PG8_STAGE(PG8_SA(0, 0), a2, voffA);
            PG8_BAR; PG8_WAIT_L(0); PG8_MMA(1, 0, At, B0); PG8_BAR; PG8_SCHED;
            PG8_STAGE(PG8_SB(0, 1), b2 + hstep, voffB);
            PG8_WAIT_V(6); PG8_BAR; PG8_MMA(1, 1, At, B1); PG8_BAR;
            PG8_LDB(B0, 1, 0); PG8_SCHED; PG8_LDA(At, 1, 0); PG8_STAGE(PG8_SA(0, 1), a2 + hstep, voffA);
            PG8_WAIT_L(8); PG8_BAR; PG8_WAIT_L(0); PG8_MMA(0, 0, At, B0); PG8_BAR; PG8_SCHED;
            PG8_LDB(B1, 1, 1); PG8_STAGE(PG8_SB(1, 0), b3, voffB);
            PG8_BAR; PG8_WAIT_L(0); PG8_MMA(0, 1, At, B1); PG8_BAR;
            PG8_LDA(At, 1, 1); PG8_STAGE(PG8_SA(1, 0), a3, voffA);
            PG8_BAR; PG8_WAIT_L(0); PG8_MMA(1, 0, At, B0); PG8_BAR; PG8_SCHED;
            PG8_STAGE(PG8_SB(1, 1), b3 + hstep, voffB);
            PG8_WAIT_V(6); PG8_BAR; PG8_MMA(1, 1, At, B1); PG8_BAR;
            }
        }
        if constexpr (ALIGN_EPI) { if (wr == 0) PG8_BAR; }
        if constexpr (!Epi::AFTER_DRAIN) { E(acc, cur, wr, wc, fr, fq); S.done(cur); }
        if (!has_next) break;
#pragma unroll
        for (int a = 0; a < 2; ++a)
#pragma unroll
            for (int b = 0; b < 2; ++b)
#pragma unroll
                for (int m = 0; m < 4; ++m)
#pragma unroll
                    for (int n = 0; n < 2; ++n) acc[a][b][m][n] = (f32x4){0.f, 0.f, 0.f, 0.f};
        cur = nxt; cA = nA; cB = nB; ++ui;
        if constexpr (ALIGN_EPI) { if (wr == 1) PG8_BAR; }
    }
    PG8_WAIT_V(0);
    if constexpr (!ALIGN_EPI) { if (wr == 0) PG8_BAR; }
    PG8_BAR;
    if constexpr (Epi::AFTER_DRAIN) { E.fused(acc, cur, wr, wc, fr, fq, lds, wid, lane); S.done(cur); }
#undef PG8_SA
#undef PG8_SB
#undef PG8_STAGE
#undef PG8_LDA
#undef PG8_LDB
#undef PG8_MMA
#undef PG8_WAIT_V
#undef PG8_WAIT_L
#undef PG8_BAR
#undef PG8_SCHED
}
}
constexpr int NWAVES = 8;
constexpr int DM = 1024, NB = 16, SEQ = 4096, MP = NB * SEQ  , SB = 128, ST = 8, MS = SB * ST  , MTOT = MP + MS  ;
constexpr int NIN = 3840;
constexpr int HA = 8, HD = 64, DA = 512, HB = 4, DKB = 64, DVB = 128, DBB = 512, RANK = 16, WIN = 2048, PAST = 8192;
constexpr float EPS = 1e-6f;
constexpr float LOG2E = 1.4426950408889634f;
constexpr float QSCALE = 0.125f * LOG2E;
constexpr size_t OUT_YP = 0, OUT_YS = OUT_YP + (size_t)MP * DM, OUT_KWIN = OUT_YS + (size_t)MS * DM, OUT_VWIN = OUT_KWIN + (size_t)NB * WIN * DA,
                 OUT_SP = OUT_VWIN + (size_t)NB * WIN * DA, OUT_KNEW = OUT_SP + (size_t)NB * HB * DKB * DVB, OUT_VNEW = OUT_KNEW + (size_t)MS * DA,
                 OUT_SS = OUT_VNEW + (size_t)MS * DA, OUT_END = OUT_SS + (size_t)SB * HB * DKB * DVB;
constexpr size_t MiB = 1u << 20;
constexpr size_t WS_CTL = 0, CTL_ZERO_BYTES = 1 * MiB;
constexpr size_t WS_WIN = 2 * MiB;
constexpr size_t WS_WOUT = 10 * MiB;
constexpr size_t WS_ROPE = 12 * MiB;
constexpr size_t WS_RSTD = 14 * MiB;
constexpr size_t WS_SCAL = 15 * MiB;
constexpr size_t WS_XB = 16 * MiB;
constexpr size_t WS_Q = 160 * MiB, WS_K = 228 * MiB, WS_V = 296 * MiB;
constexpr size_t WS_QB = 364 * MiB, WS_KB = 398 * MiB;
constexpr size_t WS_VB = 432 * MiB;
constexpr size_t WS_LOGA = 500 * MiB;
constexpr size_t WS_GA = 568 * MiB, WS_GB = 636 * MiB;
constexpr size_t WS_OPART = 704 * MiB;
constexpr size_t WS_LPART = 900 * MiB;
constexpr size_t WS_MIX = 908 * MiB;
constexpr size_t WS_END = 1040 * MiB;
constexpr size_t OPART_STRIDE = (size_t)MP * DA;
constexpr size_t LPART_STRIDE = (size_t)MP * HA;
constexpr int CW_TMO = 0, CW_CODE = 1;
constexpr int CW_TICKET = 64;
constexpr int CW_TICKET2 = 128;
constexpr int CW_P0A = 192;
constexpr int CW_BAR = 4096;
constexpr int RING_OFF = 0, RING_BYTES = 131072;
constexpr int LDSCTL_OFF = RING_BYTES, MISC_OFF = LDSCTL_OFF + 320;
constexpr int OSTAGE_OFF = LDSCTL_OFF + 512, LDS_BYTES = OSTAGE_OFF + 16384;
#define GAS __attribute__((address_space(1)))
#define LAS __attribute__((address_space(3)))
typedef unsigned short bf16;
typedef unsigned v4u __attribute__((ext_vector_type(4)));
typedef unsigned v2u __attribute__((ext_vector_type(2)));
typedef float f32x4 __attribute__((ext_vector_type(4)));
typedef float f32x2 __attribute__((ext_vector_type(2)));
typedef float f32x16 __attribute__((ext_vector_type(16)));
typedef short bf16x8 __attribute__((ext_vector_type(8)));
typedef short s16x4 __attribute__((ext_vector_type(4)));
typedef GAS unsigned gu32;
#define RLX_AGENT __ATOMIC_RELAXED, __HIP_MEMORY_SCOPE_AGENT
#define LDS_WAIT() asm volatile("s_waitcnt lgkmcnt(0)" ::: "memory")
#define VM_WAIT() asm volatile("s_waitcnt vmcnt(0)" ::: "memory")
#define LBAR() do { asm volatile("s_waitcnt lgkmcnt(0)" ::: "memory"); __builtin_amdgcn_s_barrier(); asm volatile("" ::: "memory"); } while (0)
__device__ __forceinline__ unsigned f2bf(float f) { unsigned u = __builtin_bit_cast(unsigned, f); return (u + 0x7fffu + ((u >> 16) & 1u)) >> 16; }
__device__ __forceinline__ unsigned pk2(float lo, float hi) { typedef float f2 __attribute__((ext_vector_type(2))); typedef __bf16 b2 __attribute__((ext_vector_type(2))); f2 v = {lo, hi}; b2 b = __builtin_convertvector(v, b2); return __builtin_bit_cast(unsigned, b); }
__device__ __forceinline__ float bflo(unsigned u) { return __builtin_bit_cast(float, u << 16); }
__device__ __forceinline__ float bfhi(unsigned u) { return __builtin_bit_cast(float, u & 0xffff0000u); }
__device__ __forceinline__ v4u pack8(const f32x4 a, const f32x4 b) { v4u w; w.x = pk2(a[0], a[1]); w.y = pk2(a[2], a[3]); w.z = pk2(b[0], b[1]); w.w = pk2(b[2], b[3]); return w; }
__device__ __forceinline__ float wave_sum(float v) {
#pragma unroll
    for (int o = 1; o < 64; o <<= 1) v += __shfl_xor(v, o);
    return v;
}
__device__ __forceinline__ float wave_max(float v) {
#pragma unroll
    for (int o = 1; o < 64; o <<= 1) v = fmaxf(v, __shfl_xor(v, o));
    return v;
}
__device__ __forceinline__ float fast_exp2(float x) { return __builtin_amdgcn_exp2f(x); }
__device__ __forceinline__ float fast_exp(float x) { return __builtin_amdgcn_exp2f(x * LOG2E); }
__device__ __forceinline__ float silu_f(float x) { return x * __builtin_amdgcn_rcpf(1.0f + fast_exp(-x)); }
struct TileT {
    LAS unsigned char* T; int w0, w1, wa0, wa1, ro, rr, p;
    __device__ __forceinline__ void init(LAS unsigned char* stg, int wid, int fr, int fq) {
        T = stg + wid * 2048; const int lane = fr + 16 * fq; rr = lane >> 3; p = lane & 7; const int k = fr & 7;
        w0 = fr * 128 + ((fq ^ k) << 4); w1 = fr * 128 + (((4 + fq) ^ k) << 4);
        wa0 = fr * 128 + (((2 * fq) ^ k) << 4); wa1 = fr * 128 + (((2 * fq + 1) ^ k) << 4);
        ro = rr * 128 + ((p ^ rr) << 4);
    }
    __device__ __forceinline__ void bf(const v4u x0, const v4u x1, v4u& a, v4u& b) const {
        *(LAS v4u*)(T + w0) = x0; *(LAS v4u*)(T + w1) = x1; a = *(const LAS v4u*)(T + ro); b = *(const LAS v4u*)(T + ro + 1024); }
    __device__ __forceinline__ void f4(const f32x4 x0, const f32x4 x1, f32x4& a, f32x4& b) const {
        *(LAS f32x4*)(T + wa0) = x0; *(LAS f32x4*)(T + wa1) = x1; a = *(const LAS f32x4*)(T + ro); b = *(const LAS f32x4*)(T + ro + 1024); }
};
struct EpiIn {
    static constexpr bool PERM = true, AFTER_DRAIN = false;
    const float* rstd; const float* rope; const float* nwb  ; const float* bgate;
    unsigned char* ws; float* out; LAS unsigned char* stg;
    __device__ __forceinline__ void operator()(const f32x4 (&acc)[2][2][4][2], const pg8::Unit& u, int wr, int wc, int fr, int fq) const {
        asm volatile("" : "+v"(fr), "+v"(fq));
        const int pn = u.pn, pm = u.pm;
        const bool sample = pm >= (MP / 256);
        TileT tt; tt.init(stg, wr * 4 + wc, fr, fq);
        float rs8[2][4];
#pragma unroll
        for (int ai = 0; ai < 2; ++ai)
#pragma unroll
            for (int m = 0; m < 4; ++m) rs8[ai][m] = rstd[256 * pm + 128 * ai + 64 * wr + 16 * m + fr];
        if (pn < 4) {
            const int head = 4 * (pn & 1) + wc; const bool isq = pn < 2;
            const float* nw = nwb + (isq ? 0 : 64);
            f32x4 w[2][2];
#pragma unroll
            for (int bj = 0; bj < 2; ++bj)
#pragma unroll
                for (int n = 0; n < 2; ++n) w[bj][n] = *(const f32x4*)(nw + 32 * bj + 8 * fq + 4 * n);
            bf16* dst = (bf16*)(ws + (isq ? WS_Q : WS_K));
            const bool wout = !isq && (sample || (pm & 15) >= 8);
            const int rbase = 64 * wr + fr;
            f32x4 tn[4];
            { const int ri0 = sample ? (SEQ + (rbase & 7)) : (256 * (pm & 15) + rbase); const f32x4* tp0 = (const f32x4*)(rope + (size_t)ri0 * 64 + 16 * fq);
#pragma unroll
              for (int q = 0; q < 4; ++q) tn[q] = tp0[q]; }
#pragma unroll
            for (int ai = 0; ai < 2; ++ai)
#pragma unroll
                for (int m = 0; m < 4; ++m) {
                    const int rit = 128 * ai + 16 * m + rbase;
                    f32x4 tc[4];
#pragma unroll
                    for (int q = 0; q < 4; ++q) tc[q] = tn[q];
                    if (ai * 4 + m < 7) {
                        const int ritn = rit + (m == 3 ? 80 : 16); const int rin = sample ? (SEQ + (ritn & 7)) : (256 * (pm & 15) + ritn);
                        const f32x4* tpn = (const f32x4*)(rope + (size_t)rin * 64 + 16 * fq);
#pragma unroll
                        for (int q = 0; q < 4; ++q) tn[q] = tpn[q];
                    }
                    const float rs = rs8[ai][m];
                    f32x4 x[2][2]; float ss = 0.f;
#pragma unroll
                    for (int bj = 0; bj < 2; ++bj)
#pragma unroll
                        for (int n = 0; n < 2; ++n) { x[bj][n] = acc[ai][bj][m][n] * rs; const f32x4 t = x[bj][n]; ss += (t[0] * t[0] + t[1] * t[1]) + (t[2] * t[2] + t[3] * t[3]); }
                    ss += __shfl_xor(ss, 16); ss += __shfl_xor(ss, 32);
                    const float rn = __builtin_amdgcn_rsqf(ss * (1.0f / 64.0f) + EPS);
                    f32x4 o1[2], o2[2];
#pragma unroll
                    for (int n = 0; n < 2; ++n) {
                        const f32x4 ta = tc[2 * n], tb = tc[2 * n + 1];
                        const f32x4 y1 = x[0][n] * rn * w[0][n], y2 = x[1][n] * rn * w[1][n];
                        const f32x4 c = {ta[0], ta[2], tb[0], tb[2]}, s = {ta[1], ta[3], tb[1], tb[3]};
                        o1[n] = y1 * c - y2 * s; o2[n] = y2 * c + y1 * s;
                    }
                    const int rowa = 256 * pm + 128 * ai + 64 * wr + 16 * m + tt.rr;
                    { v4u a, b; if (isq) tt.bf(pack8(o1[0] * QSCALE, o1[1] * QSCALE), pack8(o2[0] * QSCALE, o2[1] * QSCALE), a, b); else tt.bf(pack8(o1[0], o1[1]), pack8(o2[0], o2[1]), a, b);
                      bf16* d = dst + (size_t)rowa * DA + head * 64 + 8 * tt.p; *(v4u*)d = a; *(v4u*)(d + 8 * DA) = b; }
                    if (wout) {
                        const int rl = 128 * ai + 64 * wr + 16 * m + tt.rr;
                        float* op = sample ? out + OUT_KNEW + (size_t)(rowa - MP) * DA : out + OUT_KWIN + ((size_t)(pm >> 4) * WIN + (256 * (pm & 15) + rl - (SEQ - WIN))) * DA;
                        op += head * 64 + 4 * tt.p;
                        f32x4 a, b; tt.f4(o1[0], o1[1], a, b); *(f32x4*)op = a; *(f32x4*)(op + 8 * DA) = b;
                        tt.f4(o2[0], o2[1], a, b); *(f32x4*)(op + 32) = a; *(f32x4*)(op + 32 + 8 * DA) = b;
                    }
                }
        } else if (pn < 6) {
            const int head = 4 * (pn & 1) + wc;
            const bool wout = sample || (pm & 15) >= 8;
#pragma unroll
            for (int ai = 0; ai < 2; ++ai)
#pragma unroll
                for (int m = 0; m < 4; ++m) {
                    const int rl = 128 * ai + 64 * wr + 16 * m + tt.rr, rowa = 256 * pm + rl;
                    const float rs = rs8[ai][m];
                    const f32x4 a0 = acc[ai][0][m][0] * rs, a1 = acc[ai][0][m][1] * rs, b0 = acc[ai][1][m][0] * rs, b1 = acc[ai][1][m][1] * rs;
                    { v4u a, b; tt.bf(pack8(a0, a1), pack8(b0, b1), a, b);
                      bf16* d = (bf16*)(ws + WS_V) + (size_t)rowa * DA + head * 64 + 8 * tt.p; *(v4u*)d = a; *(v4u*)(d + 8 * DA) = b; }
                    if (wout) {
                        float* op = sample ? out + OUT_VNEW + (size_t)(rowa - MP) * DA : out + OUT_VWIN + ((size_t)(pm >> 4) * WIN + (256 * (pm & 15) + rl - (SEQ - WIN))) * DA;
                        op += head * 64 + 4 * tt.p;
                        f32x4 a, b; tt.f4(a0, a1, a, b); *(f32x4*)op = a; *(f32x4*)(op + 8 * DA) = b;
                        tt.f4(b0, b1, a, b); *(f32x4*)(op + 32) = a; *(f32x4*)(op + 32 + 8 * DA) = b;
                    }
                }
        } else if (pn < 8) {
            bf16* dst = (bf16*)(ws + (pn == 6 ? WS_QB : WS_KB)); const float sc = pn == 6 ? 0.125f : 1.0f;
#pragma unroll
            for (int ai = 0; ai < 2; ++ai)
#pragma unroll
                for (int m = 0; m < 4; ++m) {
                    const int rowa = 256 * pm + 128 * ai + 64 * wr + 16 * m + tt.rr;
                    const float rs = rs8[ai][m] * sc;
                    v4u a, b; tt.bf(pack8(acc[ai][0][m][0] * rs, acc[ai][0][m][1] * rs), pack8(acc[ai][1][m][0] * rs, acc[ai][1][m][1] * rs), a, b);
                    bf16* d = dst + (size_t)rowa * 256 + wc * 64 + 8 * tt.p; *(v4u*)d = a; *(v4u*)(d + 8 * 256) = b;
                }
        } else if (pn < 14) {
            bf16* dst = (bf16*)(ws + (pn < 10 ? WS_VB : (pn < 12 ? WS_GA : WS_GB))); const bool act = pn >= 10;
            const int cb = 256 * (pn & 1) + 64 * wc + 8 * tt.p;
#pragma unroll
            for (int ai = 0; ai < 2; ++ai)
#pragma unroll
                for (int m = 0; m < 4; ++m) {
                    const int rowa = 256 * pm + 128 * ai + 64 * wr + 16 * m + tt.rr;
                    const float rs = rs8[ai][m];
                    v4u pk[2];
#pragma unroll
                    for (int bj = 0; bj < 2; ++bj) {
                        f32x4 a = acc[ai][bj][m][0] * rs, b = acc[ai][bj][m][1] * rs;
                        if (act) {
#pragma unroll
                            for (int j = 0; j < 4; ++j) { a[j] = silu_f(a[j]); b[j] = silu_f(b[j]); }
                        }
                        pk[bj] = pack8(a, b);
                    }
                    v4u a, b; tt.bf(pk[0], pk[1], a, b);
                    bf16* d = dst + (size_t)rowa * 512 + cb; *(v4u*)d = a; *(v4u*)(d + 8 * 512) = b;
                }
        } else {
            f32x4 bg[2][2];
#pragma unroll
            for (int bj = 0; bj < 2; ++bj)
#pragma unroll
                for (int n = 0; n < 2; ++n) bg[bj][n] = *(const f32x4*)(bgate + 64 * wc + 32 * bj + 8 * fq + 4 * n);
#pragma unroll
            for (int ai = 0; ai < 2; ++ai)
#pragma unroll
                for (int m = 0; m < 4; ++m) {
                    const int rowa = 256 * pm + 128 * ai + 64 * wr + 16 * m + tt.rr;
                    const float rs = rs8[ai][m];
                    v4u pk[2];
#pragma unroll
                    for (int bj = 0; bj < 2; ++bj) {
                        f32x4 r2[2];
#pragma unroll
                        for (int n = 0; n < 2; ++n) {
                            const f32x4 z = acc[ai][bj][m][n] * rs + bg[bj][n];
#pragma unroll
                            for (int j = 0; j < 4; ++j) { const float az = fabsf(z[j]); r2[n][j] = (fminf(z[j], 0.f) - __logf(1.0f + fast_exp(-az))) * (1.0f / 16.0f); }
                        }
                        pk[bj] = pack8(r2[0], r2[1]);
                    }
                    v4u a, b; tt.bf(pk[0], pk[1], a, b);
                    bf16* d = (bf16*)(ws + WS_LOGA) + (size_t)rowa * 256 + 64 * wc + 8 * tt.p; *(v4u*)d = a; *(v4u*)(d + 8 * 256) = b;
                }
        }
    }
};
struct EpiOut {
    static constexpr bool PERM = false, AFTER_DRAIN = false;
    const bf16* xbf; float* out; LAS unsigned char* stg;
    __device__ __forceinline__ void operator()(const f32x4 (&acc)[2][2][4][2], const pg8::Unit& u, int wr, int wc, int fr, int fq) const {
        asm volatile("" : "+v"(fr), "+v"(fq));
        const int pm = u.pm; const bool sample = pm >= (MP / 256);
        const bf16* xb = xbf + (size_t)pm * 256 * DM;
        float* ob = sample ? out + OUT_YS + (size_t)(pm - MP / 256) * 256 * DM : out + OUT_YP + (size_t)pm * 256 * DM;
        LAS unsigned char* T = stg + (wr * 4 + wc) * 2048;
        const int lane = fr + 16 * fq, rr = lane >> 3, p = lane & 7;
        const int woff0 = fr * 128 + ((fq ^ (fr & 7)) << 4), woff1 = fr * 128 + (((4 + fq) ^ (fr & 7)) << 4);
        const int roff = rr * 128 + ((p ^ rr) << 4);
        const int cb = 256 * u.pn + 32 * wc + 4 * p;
#pragma unroll
        for (int ai = 0; ai < 2; ++ai) {
            v4u xv[4][2][2];
#pragma unroll
            for (int m = 0; m < 4; ++m) {
                const size_t ro = (size_t)(128 * ai + 64 * wr + 16 * m + rr) * DM + (cb & ~7);
#pragma unroll
                for (int bj = 0; bj < 2; ++bj) { xv[m][bj][0] = *(const v4u*)(xb + ro + 128 * bj); xv[m][bj][1] = *(const v4u*)(xb + ro + 8 * DM + 128 * bj); }
            }
#pragma unroll
            for (int m = 0; m < 4; ++m) {
                const size_t ro = (size_t)(128 * ai + 64 * wr + 16 * m + rr) * DM + cb;
#pragma unroll
                for (int bj = 0; bj < 2; ++bj) {
                    *(LAS f32x4*)(T + woff0) = acc[ai][bj][m][0]; *(LAS f32x4*)(T + woff1) = acc[ai][bj][m][1];
                    const f32x4 a0 = *(const LAS f32x4*)(T + roff), a1 = *(const LAS f32x4*)(T + roff + 1024);
                    const v4u t0 = xv[m][bj][0], t1 = xv[m][bj][1];
                    const unsigned u0 = (p & 1) ? t0.z : t0.x, u1 = (p & 1) ? t0.w : t0.y, u2 = (p & 1) ? t1.z : t1.x, u3 = (p & 1) ? t1.w : t1.y;
                    *(f32x4*)(ob + ro + 128 * bj) = (f32x4){bflo(u0), bfhi(u0), bflo(u1), bfhi(u1)} + a0; *(f32x4*)(ob + ro + 8 * DM + 128 * bj) = (f32x4){bflo(u2), bfhi(u2), bflo(u3), bfhi(u3)} + a1;
                }
            }
        }
    }
};
#define XB_TMO      128
#define XB_XCNT(j)  (256  + 64 * (j))
#define XB_XSUB(j)  (1280 + 64 * (j))
#define XB_XGEN(j)  (2304 + 64 * (j))
#define XB_TOP      3328
#define XB_TOPGEN   3392
#define XCD_BAR_WORDS 3456
#define XB_SPIN_CAP (1u << 18)

__device__ __forceinline__ unsigned xb_ld(unsigned* p)              { return __hip_atomic_load(p, __ATOMIC_RELAXED, __HIP_MEMORY_SCOPE_AGENT); }
__device__ __forceinline__ unsigned xb_add(unsigned* p, unsigned v) { return __hip_atomic_fetch_add(p, v, __ATOMIC_RELAXED, __HIP_MEMORY_SCOPE_AGENT); }
__device__ __forceinline__ unsigned xb_xcc_id() { return (unsigned)__builtin_amdgcn_s_getreg((3 << 11) | 20) & 0xFu; }
#define XB_SPIN(cond, bar) do { unsigned _sp = 0; while (cond) { __builtin_amdgcn_s_sleep(1); \
    if ((++_sp & 255u) == 0u) { if (xb_ld(&(bar)[XB_TMO])) break; if (_sp > XB_SPIN_CAP) { atomicAdd(&(bar)[XB_TMO], 1u); break; } } } } while (0)

struct XcdBarrier {
    unsigned* bar; unsigned x;
    volatile LAS unsigned* st;
};

__device__ __forceinline__ XcdBarrier xcd_barrier_post(unsigned* bar, volatile LAS unsigned* st) {
    XcdBarrier b; b.bar = bar; b.x = xb_xcc_id(); b.st = st;
    if (threadIdx.x == 0) (void)xb_add(&bar[XB_XCNT(b.x)], 1u);
    return b;
}
__device__ __forceinline__ void xcd_barrier_complete(unsigned* bar, unsigned x, unsigned& nloc, unsigned& nx) {
    const unsigned G = gridDim.x * gridDim.y * gridDim.z;
    unsigned sum, cnt, mine, sp = 0u;
    for (;;) {
        sum = 0u; cnt = 0u; mine = 0u;
#pragma unroll
        for (unsigned j = 0; j < 16; ++j) { const unsigned c = xb_ld(&bar[XB_XCNT(j)]); sum += c; cnt += (c > 0u) ? 1u : 0u; mine = (j == x) ? c : mine; }
        if (sum == G) break;
        __builtin_amdgcn_s_sleep(1);
        if ((++sp & 255u) == 0u) { if (xb_ld(&bar[XB_TMO])) break; if (sp > XB_SPIN_CAP) { atomicAdd(&bar[XB_TMO], 1u); break; } }
    }
    nloc = mine > 0u ? mine : 1u; nx = cnt > 0u ? cnt : 1u;
}

__device__ __forceinline__ void xcd_barrier(const XcdBarrier& b) {
    asm volatile("s_waitcnt vmcnt(0)" ::: "memory");
    __syncthreads();
    if (threadIdx.x == 0) {
        unsigned* bar = b.bar;
        __builtin_amdgcn_s_waitcnt(0);
        unsigned nloc = b.st[0], nx = b.st[1];
        if (nloc == 0u) { xcd_barrier_complete(bar, b.x, nloc, nx); b.st[0] = nloc; b.st[1] = nx; }
        const unsigned old = xb_add(&bar[XB_XSUB(b.x)], 1u);
        const unsigned gen = old / nloc;
        if (old + 1u == (gen + 1u) * nloc) {
            __builtin_amdgcn_fence(__ATOMIC_RELEASE, "agent");
            asm volatile("s_waitcnt vmcnt(0)" ::: "memory");
            const unsigned og = xb_add(&bar[XB_TOP], 1u);
            const unsigned tg = og / nx;
            if (og + 1u == (tg + 1u) * nx) xb_add(&bar[XB_TOPGEN], 1u);
            else XB_SPIN(xb_ld(&bar[XB_TOPGEN]) == tg, bar);
            __builtin_amdgcn_fence(__ATOMIC_ACQUIRE, "agent");
            xb_add(&bar[XB_XGEN(b.x)], 1u);
            asm volatile("s_waitcnt vmcnt(0)" ::: "memory");
        } else {
            XB_SPIN(xb_ld(&bar[XB_XGEN(b.x)]) == gen, bar);
            __builtin_amdgcn_fence(__ATOMIC_ACQUIRE, "agent");
            asm volatile("s_waitcnt vmcnt(0)" ::: "memory");
        }
    }
    __syncthreads();
}
struct Args { const float* in[13]; float* out; unsigned char* ws; int ph_lo, ph_hi, item_mask, pad; };
struct Frame {
    LAS unsigned char* lds; volatile LAS unsigned* MISC; gu32* ctl;
    int tid, lane, wave, G, item_mask;
    float* out; unsigned char* ws;
};
__device__ __forceinline__ const Args* args_ptr() {
#if defined(__HIP_DEVICE_COMPILE__)
    const void* p = (const void*)__builtin_amdgcn_kernarg_segment_ptr(); asm volatile("" : "+s"(p)); return (const Args*)p;
#else
    return nullptr;
#endif
}
#define INP(k) (args_ptr()->in[k])
enum { I_XP = 0, I_XS, I_CK, I_CV, I_SG, I_NORMW, I_WIN, I_WGU, I_BGATE, I_QNW, I_KNW, I_GNW, I_WOUT };
#define WSP(T, off) ((T*)(F.ws + (off)))

__device__ __forceinline__ void p0_transpose_item(const float* W, int ldw, int srccol0, const float* kscale, bf16* WT, int K, int dstrow0, LAS float* scr, int k0, int lane) {
    float wv[32], sv[32];
#pragma unroll
    for (int i = 0; i < 32; ++i) { const int kk = 2 * i + (lane >> 5); wv[i] = W[(size_t)(k0 + kk) * ldw + srccol0 + (lane & 31)]; }
#pragma unroll
    for (int i = 0; i < 32; ++i) { const int kk = 2 * i + (lane >> 5); sv[i] = kscale ? kscale[k0 + kk] : 1.0f; }
#pragma unroll
    for (int i = 0; i < 32; ++i) { const int kk = 2 * i + (lane >> 5); scr[kk * 33 + (lane & 31)] = wv[i] * sv[i]; }
    LDS_WAIT(); asm volatile("" ::: "memory");
    const int c = lane & 7;
#pragma unroll
    for (int j = 0; j < 4; ++j) { const int n = (lane >> 3) + 8 * j; const LAS float* s = scr + (8 * c) * 33 + n;
        v4u o; o.x = pk2(s[0 * 33], s[1 * 33]); o.y = pk2(s[2 * 33], s[3 * 33]); o.z = pk2(s[4 * 33], s[5 * 33]); o.w = pk2(s[6 * 33], s[7 * 33]);
        *(v4u*)(WT + (size_t)(dstrow0 + n) * K + k0 + 8 * c) = o; }
    LDS_WAIT(); asm volatile("" ::: "memory");
}
__device__ __forceinline__ int in_src_col(int n0) {
    const int pn = n0 >> 8, within = n0 & 255, bj = within >> 7, wc = (within & 127) >> 5;
    if (pn < 6) return 512 * (pn >> 1) + 64 * (4 * (pn & 1) + wc) + 32 * bj;
    if (pn == 6) return 1536 + 64 * wc + 32 * bj;
    if (pn == 7) return 1792 + 64 * wc + 32 * bj;
    if (pn < 10) return 2048 + 256 * (pn - 8) + 64 * wc + 32 * bj;
    if (pn < 12) return 2576 + 256 * (pn - 10) + 64 * wc + 32 * bj;
    return 3088 + 256 * (pn - 12) + 64 * wc + 32 * bj;
}
__device__ __forceinline__ void p0_convert_row(Frame& F, const float* xp_, const float* xs_, int m) {
    const float* xrow = m < MP ? xp_ + (size_t)m * DM : xs_ + (size_t)(m - MP) * DM;
    const f32x4* xr = (const f32x4*)xrow + F.lane;
    f32x4 v[4]; float s = 0.f;
#pragma unroll
    for (int j = 0; j < 4; ++j) { v[j] = xr[64 * j]; s += (v[j][0] * v[j][0] + v[j][1] * v[j][1]) + (v[j][2] * v[j][2] + v[j][3] * v[j][3]); }
    s = wave_sum(s);
    if (F.lane == 0) WSP(float, WS_RSTD)[m] = 1.0f / sqrtf(s * (1.0f / DM) + EPS);
    v2u* o8 = (v2u*)(WSP(bf16, WS_XB) + (size_t)m * DM) + F.lane;
#pragma unroll
    for (int j = 0; j < 4; ++j) { v2u o; o.x = pk2(v[j][0], v[j][1]); o.y = pk2(v[j][2], v[j][3]); o8[64 * j] = o; }
}
__device__ __forceinline__ void p0_convert_row2(Frame& F, const float* xp_, int m0, int m1) {
    const f32x4* xa = (const f32x4*)(xp_ + (size_t)m0 * DM) + F.lane; const f32x4* xb = (const f32x4*)(xp_ + (size_t)m1 * DM) + F.lane;
    f32x4 va[4], vb[4]; float sa = 0.f, sb = 0.f;
#pragma unroll
    for (int j = 0; j < 4; ++j) { va[j] = xa[64 * j]; vb[j] = xb[64 * j]; }
#pragma unroll
    for (int j = 0; j < 4; ++j) { sa += (va[j][0] * va[j][0] + va[j][1] * va[j][1]) + (va[j][2] * va[j][2] + va[j][3] * va[j][3]); sb += (vb[j][0] * vb[j][0] + vb[j][1] * vb[j][1]) + (vb[j][2] * vb[j][2] + vb[j][3] * vb[j][3]); }
    sa = wave_sum(sa); sb = wave_sum(sb);
    if (F.lane == 0) { WSP(float, WS_RSTD)[m0] = 1.0f / sqrtf(sa * (1.0f / DM) + EPS); WSP(float, WS_RSTD)[m1] = 1.0f / sqrtf(sb * (1.0f / DM) + EPS); }
    v2u* oa = (v2u*)(WSP(bf16, WS_XB) + (size_t)m0 * DM) + F.lane; v2u* ob = (v2u*)(WSP(bf16, WS_XB) + (size_t)m1 * DM) + F.lane;
#pragma unroll
    for (int j = 0; j < 4; ++j) { v2u o; o.x = pk2(va[j][0], va[j][1]); o.y = pk2(va[j][2], va[j][3]); oa[64 * j] = o; v2u p; p.x = pk2(vb[j][0], vb[j][1]); p.y = pk2(vb[j][2], vb[j][3]); ob[64 * j] = p; }
}
__device__ __forceinline__ void p0_prologue(Frame& F) {
    const Args* A_ = args_ptr();
    const float *xp_ = A_->in[I_XP], *xs_ = A_->in[I_XS], *normw_ = A_->in[I_NORMW], *win_ = A_->in[I_WIN], *wgu_ = A_->in[I_WGU], *qnw_ = A_->in[I_QNW], *knw_ = A_->in[I_KNW], *wout_ = A_->in[I_WOUT];
    LAS float* scr = (LAS float*)(F.lds + RING_OFF + F.wave * 16384);
    bf16* WinT = WSP(bf16, WS_WIN); bf16* WoutT = WSP(bf16, WS_WOUT);
    const int bx = (int)blockIdx.x;
    constexpr int G_TR = 144, G_GW = 32, G_RO = 16;
    if (bx < G_TR) {
        constexpr int I_IN = 112 * 16, I_OUT = 32 * 16;
        for (int it = bx * NWAVES + F.wave; it < I_IN + I_OUT; it += G_TR * NWAVES) {
            if (it < I_IN) { const int ng = it >> 4, kb = it & 15; p0_transpose_item(win_, 3600, in_src_col(32 * ng), normw_, WinT, DM, 32 * ng, scr, 64 * kb, F.lane); }
            else { const int r = it - I_IN, ng = r >> 4, kb = r & 15; p0_transpose_item(wout_, DM, 32 * ng, nullptr, WoutT, DM, 32 * ng, scr, 64 * kb, F.lane); }
        }
    } else if (bx < G_TR + G_GW) {
        for (int it = (bx - G_TR) * (NWAVES * 64) + F.tid; it < 256 * 128; it += G_GW * NWAVES * 64) {
            const int c = it & 255, k8 = it >> 8; float r[8];
            const int lc = 64 * ((c >> 5) & 3) + 32 * (c >> 7) + (c & 31);
#pragma unroll
            for (int kk = 0; kk < 8; ++kk) { const int k = 8 * k8 + kk; const float* wr_ = win_ + (size_t)k * 3600 + 2560; float s = 0.f;
#pragma unroll
                for (int q = 0; q < RANK; ++q) s += wr_[q] * wgu_[q * 256 + lc];
                r[kk] = s * normw_[k]; }
            v4u o; o.x = pk2(r[0], r[1]); o.y = pk2(r[2], r[3]); o.z = pk2(r[4], r[5]); o.w = pk2(r[6], r[7]);
            *(v4u*)(WinT + (size_t)(3584 + c) * DM + 8 * k8) = o;
        }
    } else if (bx < G_TR + G_GW + G_RO) {
        float* rope = WSP(float, WS_ROPE);
        for (int it = (bx - G_TR - G_GW) * (NWAVES * 64) + F.tid; it < (SEQ + ST) * 32; it += G_RO * NWAVES * 64) {
            const int ri = it >> 5, d = it & 31; const float pos = (float)(ri < SEQ ? ri : PAST + (ri - SEQ));
            const float invf = exp2f(-(float)d * (13.287712379549449f / 32.0f));
            float s, c; sincosf(pos * invf, &s, &c);
            rope[2 * it] = c; rope[2 * it + 1] = s;
        }
        if (bx == G_TR + G_GW && F.wave == 0) {
            const float mq = wave_max(fabsf(qnw_[F.lane])), mk = wave_max(fabsf(knw_[F.lane]));
            if (F.lane == 0) WSP(float, WS_SCAL)[0] = 8.0f * LOG2E * mq * mk;
            WSP(float, WS_SCAL)[64 + F.lane] = qnw_[F.lane]; WSP(float, WS_SCAL)[128 + F.lane] = knw_[F.lane];
        }
    } else {
        const int ng = F.G - (G_TR + G_GW + G_RO);
        for (int m = MP + (bx - (G_TR + G_GW + G_RO)) * NWAVES + F.wave; m < MTOT; m += ng * NWAVES) p0_convert_row(F, xp_, xs_, m);
    }
}
__device__ __forceinline__ void p0b_convert(Frame& F) {
    const Args* A_ = args_ptr(); const float *xp_ = A_->in[I_XP], *xs_ = A_->in[I_XS];
    if (F.tid == 0) F.MISC[5] = __hip_atomic_fetch_add(F.ctl + CW_TICKET2, 1u, RLX_AGENT);
    LBAR(); int t = __builtin_amdgcn_readfirstlane((int)F.MISC[5]); LBAR();
    while (t < MP / 64) {
        unsigned nt = 0u;
        if (F.tid == 0) nt = __hip_atomic_fetch_add(F.ctl + CW_TICKET2, 1u, RLX_AGENT);
#pragma unroll 1
        for (int i = 0; i < 8; i += 2) p0_convert_row2(F, xp_, 64 * t + 8 * i + F.wave, 64 * t + 8 * (i + 1) + F.wave);
        if (F.tid == 0) F.MISC[5] = nt;
        LBAR(); t = __builtin_amdgcn_readfirstlane((int)F.MISC[5]); LBAR();
    }
}
typedef short v4i16_t __attribute__((ext_vector_type(4)));
__device__ __forceinline__ s16x4 tr16(const LAS unsigned char* p) { return __builtin_bit_cast(s16x4, __builtin_amdgcn_ds_read_tr16_b64_v4i16((LAS v4i16_t*)p)); }
__device__ __forceinline__ bf16x8 cat8(s16x4 lo, s16x4 hi) { return (bf16x8){lo[0], lo[1], lo[2], lo[3], hi[0], hi[1], hi[2], hi[3]}; }
__device__ __forceinline__ bf16x8 pk8(f32x4 a, f32x4 b) { return __builtin_bit_cast(bf16x8, pack8(a, b)); }
#define MFMA16(a, b, c) __builtin_amdgcn_mfma_f32_16x16x32_bf16((a), (b), (c), 0, 0, 0)
#define MFMA32(a, b, c) __builtin_amdgcn_mfma_f32_32x32x16_bf16((a), (b), (c), 0, 0, 0)

constexpr int G_QT = 0, G_RP = 144, G_KT = 9216, G_V = 18432, G_VP = 288, G_P = 36864, G_O = 46080, G_OP = 528, G_TOT = 79872, G_D = 83968;
__device__ __forceinline__ void gla_prompt_item(Frame& F, int b, int h) {
    int tid = F.tid; asm volatile("" : "+v"(tid));
    const int lane = tid & 63, w = __builtin_amdgcn_readfirstlane(tid >> 6), g = lane >> 4, i16 = lane & 15;
    LAS unsigned char* L = F.lds + RING_OFF;
    const bf16* QBp = WSP(bf16, WS_QB); const bf16* KBp = WSP(bf16, WS_KB); const bf16* VBp = WSP(bf16, WS_VB); const bf16* GBp = WSP(bf16, WS_GB);
    const bf16* LOGA = WSP(bf16, WS_LOGA); bf16* MIX = WSP(bf16, WS_MIX);
#ifdef PROBE_VARIANTS
    const int var = F.item_mask >> 8;
    if (var) MIX = WSP(bf16, (size_t)1100 * MiB);
#else
    constexpr int var = 0;
#endif
    const size_t tokb = (size_t)b * SEQ;
    const int kp = tid & 31, seg = tid >> 5;
    const int et = tid >> 3, evc = tid & 7;
    f32x4 gw4[4];
#pragma unroll
    for (int q = 0; q < 4; ++q) gw4[q] = *(const f32x4*)(INP(I_GNW) + 16 * evc + 4 * q);
    f32x4 sacc[4];
#pragma unroll
    for (int kb = 0; kb < 4; ++kb) sacc[kb] = (f32x4){0.f, 0.f, 0.f, 0.f};
    f32x2 lg[4]; unsigned qv[4], kv[4]; v4u vv[2]; v4u gg[2]; v4u outp[2] = {};
#define GLA_LOAD(n) do { const size_t t0_ = tokb + 64 * (size_t)(n); \
        _Pragma("unroll") for (int i = 0; i < 4; ++i) { const size_t tk = t0_ + 4 * seg + i; { const unsigned lr_ = *(const unsigned*)(LOGA + tk * 256 + h * 64 + 2 * kp); lg[i] = (f32x2){bflo(lr_), bfhi(lr_)}; } \
            qv[i] = *(const unsigned*)(QBp + tk * 256 + h * 64 + 2 * kp); kv[i] = *(const unsigned*)(KBp + tk * 256 + h * 64 + 2 * kp); } \
        _Pragma("unroll") for (int i = 0; i < 2; ++i) { const int p_ = tid + 512 * i, row_ = p_ >> 4, c_ = p_ & 15; vv[i] = *(const v4u*)(VBp + (t0_ + row_) * 512 + h * 128 + 8 * c_); } } while (0)
    GLA_LOAD(0);
    for (int n = 0; n < SEQ / 64; ++n) {
        const size_t t0 = tokb + 64 * (size_t)n;
        f32x2 cs[4]; cs[0] = lg[0];
#pragma unroll
        for (int i = 1; i < 4; ++i) cs[i] = cs[i - 1] + lg[i];
        *(LAS f32x2*)(L + G_TOT + (seg * 64 + 2 * kp) * 4) = cs[3];
#pragma unroll
        for (int i = 0; i < 2; ++i) { const int p_ = tid + 512 * i, row_ = p_ >> 4, c_ = p_ & 15; *(LAS v4u*)(L + G_V + row_ * G_VP + c_ * 16) = vv[i]; }
        LBAR();
        if (n > 0) {
#pragma unroll
            for (int i = 0; i < 2; ++i) *(v4u*)(MIX + (t0 - 64 + et) * DM + DA + h * 128 + 16 * evc + 8 * i) = outp[i];
        }
        f32x2 pre = {0.f, 0.f}, tot = {0.f, 0.f};
#pragma unroll
        for (int s = 0; s < 16; ++s) { const f32x2 v = *(const LAS f32x2*)(L + G_TOT + (s * 64 + 2 * kp) * 4); if (s < seg) pre += v; tot += v; }
#pragma unroll
        for (int i = 0; i < 4; ++i) {
            f32x2 bb = pre + cs[i]; bb.x = fmaxf(bb.x, -80.f); bb.y = fmaxf(bb.y, -80.f);
            const float ep0 = fast_exp(bb.x), ep1 = fast_exp(bb.y), em0 = fast_exp(-bb.x), em1 = fast_exp(-bb.y);
            const int t = 4 * seg + i;
            *(LAS unsigned*)(L + G_QT + t * G_RP + kp * 4) = pk2(bflo(qv[i]) * ep0, bfhi(qv[i]) * ep1);
            *(LAS unsigned*)(L + G_KT + t * G_RP + kp * 4) = pk2(bflo(kv[i]) * em0, bfhi(kv[i]) * em1);
        }
        if (seg == 0) { f32x2 dd; dd.x = fast_exp(fmaxf(tot.x, -80.f)); dd.y = fast_exp(fmaxf(tot.y, -80.f)); *(LAS f32x2*)(L + G_D + 2 * kp * 4) = dd; }
#pragma unroll
        for (int i = 0; i < 2; ++i) gg[i] = *(const v4u*)(GBp + (t0 + et) * 512 + h * 128 + 16 * evc + 8 * i);
        if (n + 1 < SEQ / 64 && var != 2) GLA_LOAD(n + 1);
        LBAR();
        if (var != 3) {
            const int tb = w >> 1;
#pragma unroll
            for (int q2 = 0; q2 < 2; ++q2) {
                const int sb = 2 * (w & 1) + q2;
                f32x4 c4 = {0.f, 0.f, 0.f, 0.f};
                if (sb <= tb) {
#pragma unroll
                    for (int sp = 0; sp < 2; ++sp) {
                        const bf16x8 a = *(const LAS bf16x8*)(L + G_KT + (16 * sb + i16) * G_RP + (32 * sp + 8 * g) * 2);
                        const bf16x8 bq = *(const LAS bf16x8*)(L + G_QT + (16 * tb + i16) * G_RP + (32 * sp + 8 * g) * 2);
                        c4 = MFMA16(a, bq, c4);
                    }
                }
                const int t = 16 * tb + i16, s0 = 16 * sb + 4 * g;
#pragma unroll
                for (int r = 0; r < 4; ++r) if (s0 + r > t) c4[r] = 0.f;
                v2u pk; pk.x = pk2(c4[0], c4[1]); pk.y = pk2(c4[2], c4[3]);
                *(LAS v2u*)(L + G_P + t * G_RP + s0 * 2) = pk;
            }
        }
        LBAR();
        if (var != 1) {
            bf16x8 vf[2];
#pragma unroll
            for (int sp = 0; sp < 2; ++sp) { const LAS unsigned char* vp = L + G_V + (32 * sp + 8 * g + (i16 >> 2)) * G_VP + (16 * w + 4 * (i16 & 3)) * 2; vf[sp] = cat8(tr16(vp), tr16(vp + 4 * G_VP)); }
            bf16x8 pa[4][2], qa[4][2];
#pragma unroll
            for (int tb = 0; tb < 4; ++tb)
#pragma unroll
                for (int sp = 0; sp < 2; ++sp) {
                    if (!(sp == 1 && tb < 2)) pa[tb][sp] = *(const LAS bf16x8*)(L + G_P + (16 * tb + i16) * G_RP + (32 * sp + 8 * g) * 2);
                    const v2u a0 = *(const LAS v2u*)(L + G_QT + (16 * tb + i16) * G_RP + (32 * sp + 4 * g) * 2);
                    const v2u a1 = *(const LAS v2u*)(L + G_QT + (16 * tb + i16) * G_RP + (32 * sp + 16 + 4 * g) * 2);
                    v4u aa; aa.x = a0.x; aa.y = a0.y; aa.z = a1.x; aa.w = a1.y; qa[tb][sp] = __builtin_bit_cast(bf16x8, aa);
                }
            bf16x8 bs[2];
#pragma unroll
            for (int sp = 0; sp < 2; ++sp) bs[sp] = pk8(sacc[2 * sp], sacc[2 * sp + 1]);
            __builtin_amdgcn_sched_barrier(0);
            f32x4 oacc[4];
#pragma unroll
            for (int tb = 0; tb < 4; ++tb) oacc[tb] = MFMA16(qa[tb][0], bs[0], ((f32x4){0.f, 0.f, 0.f, 0.f}));
#pragma unroll
            for (int tb = 0; tb < 4; ++tb) oacc[tb] = MFMA16(qa[tb][1], bs[1], oacc[tb]);
#pragma unroll
            for (int tb = 0; tb < 4; ++tb) oacc[tb] = MFMA16(pa[tb][0], vf[0], oacc[tb]);
#pragma unroll
            for (int tb = 2; tb < 4; ++tb) oacc[tb] = MFMA16(pa[tb][1], vf[1], oacc[tb]);
            __builtin_amdgcn_sched_barrier(0);
            bf16x8 ka[4][2]; f32x4 dv[4];
#pragma unroll
            for (int kb = 0; kb < 4; ++kb) {
#pragma unroll
                for (int sp = 0; sp < 2; ++sp) { const LAS unsigned char* kq = L + G_KT + (32 * sp + 8 * g + (i16 >> 2)) * G_RP + (16 * kb + 4 * (i16 & 3)) * 2; ka[kb][sp] = cat8(tr16(kq), tr16(kq + 4 * G_RP)); }
                dv[kb] = *(const LAS f32x4*)(L + G_D + (16 * kb + 4 * g) * 4);
            }
#pragma unroll
            for (int tb = 0; tb < 4; ++tb)
#pragma unroll
                for (int r = 0; r < 4; ++r) *(LAS float*)(L + G_O + (16 * tb + 4 * g + r) * G_OP + (16 * w + i16) * 4) = oacc[tb][r];
            __builtin_amdgcn_sched_barrier(0);
#pragma unroll
            for (int kb = 0; kb < 4; ++kb) sacc[kb] = MFMA16(ka[kb][0], vf[0], sacc[kb]);
#pragma unroll
            for (int kb = 0; kb < 4; ++kb) sacc[kb] = MFMA16(ka[kb][1], vf[1], sacc[kb]);
#pragma unroll
            for (int kb = 0; kb < 4; ++kb) sacc[kb] = sacc[kb] * dv[kb];
        }
        LBAR();
        {
            f32x4 o4[4]; float ss = 0.f;
#pragma unroll
            for (int q = 0; q < 4; ++q) { o4[q] = *(const LAS f32x4*)(L + G_O + et * G_OP + (16 * evc + 4 * q) * 4); ss += (o4[q][0] * o4[q][0] + o4[q][1] * o4[q][1]) + (o4[q][2] * o4[q][2] + o4[q][3] * o4[q][3]); }
            ss += __shfl_xor(ss, 1); ss += __shfl_xor(ss, 2); ss += __shfl_xor(ss, 4);
            const float rn = __builtin_amdgcn_rsqf(ss * (1.0f / 128.0f) + EPS);
#pragma unroll
            for (int i = 0; i < 2; ++i) {
                const f32x4 ga = {bflo(gg[i].x), bfhi(gg[i].x), bflo(gg[i].y), bfhi(gg[i].y)}, gb = {bflo(gg[i].z), bfhi(gg[i].z), bflo(gg[i].w), bfhi(gg[i].w)};
                const f32x4 ra = o4[2 * i] * rn * gw4[2 * i] * ga, rb = o4[2 * i + 1] * rn * gw4[2 * i + 1] * gb;
                outp[i] = pack8(ra, rb);
            }
        }
    }
#pragma unroll
    for (int i = 0; i < 2; ++i) *(v4u*)(MIX + (tokb + 64 * (size_t)(SEQ / 64 - 1) + et) * DM + DA + h * 128 + 16 * evc + 8 * i) = outp[i];
#undef GLA_LOAD
    float* so = (var ? WSP(float, (size_t)1300 * MiB) : F.out + OUT_SP) + ((size_t)(b * HB + h) * DKB) * DVB;
#pragma unroll
    for (int kb = 0; kb < 4; ++kb)
#pragma unroll
        for (int r = 0; r < 4; ++r) so[(size_t)(16 * kb + 4 * g + r) * DVB + 16 * w + i16] = sacc[kb][r];
    LBAR();
}

__device__ __forceinline__ void gla_sample_item(Frame& F, int b, int h) {
    int tid = F.tid; asm volatile("" : "+v"(tid));
    const int lane = tid & 63, w = __builtin_amdgcn_readfirstlane(tid >> 6);
    LAS float* LA = (LAS float*)(F.lds + RING_OFF);
    LAS float* LK = LA + 512; LAS float* LQ = LK + 512;
    LAS float* LV = LQ + 512;
    LAS float* LO = LV + 1024;
    const bf16* QBp = WSP(bf16, WS_QB); const bf16* KBp = WSP(bf16, WS_KB); const bf16* VBp = WSP(bf16, WS_VB); const bf16* GBp = WSP(bf16, WS_GB);
    const bf16* LOGA = WSP(bf16, WS_LOGA); bf16* MIX = WSP(bf16, WS_MIX);
    const size_t row0 = (size_t)MP + 8 * b;
    { const int t = tid >> 6, k = tid & 63; const size_t r = row0 + t;
      LA[tid] = fast_exp(bflo((unsigned)LOGA[r * 256 + h * 64 + k]));
      LK[tid] = bflo((unsigned)KBp[r * 256 + h * 64 + k]); LQ[tid] = bflo((unsigned)QBp[r * 256 + h * 64 + k]);
#pragma unroll
      for (int i = 0; i < 2; ++i) { const int e = tid + 512 * i, tt = e >> 7, v = e & 127; LV[e] = bflo((unsigned)VBp[(row0 + tt) * 512 + h * 128 + v]); } }
    const int v = tid & 127, kq = tid >> 7;
    const float* sin_ = INP(I_SG) + ((size_t)(b * HB + h) * DKB + 16 * kq) * DVB + v;
    float S[16];
#pragma unroll
    for (int i = 0; i < 16; ++i) S[i] = sin_[(size_t)i * DVB];
    LBAR();
#pragma unroll
    for (int t = 0; t < 8; ++t) {
        const float vt = LV[t * 128 + v]; float po = 0.f;
#pragma unroll
        for (int i = 0; i < 16; ++i) { const int k = 16 * kq + i; S[i] = LA[t * 64 + k] * S[i] + LK[t * 64 + k] * vt; po += LQ[t * 64 + k] * S[i]; }
        LO[(t * 4 + kq) * 128 + v] = po;
    }
    float* sout = F.out + OUT_SS + ((size_t)(b * HB + h) * DKB + 16 * kq) * DVB + v;
#pragma unroll
    for (int i = 0; i < 16; ++i) sout[(size_t)i * DVB] = S[i];
    LBAR();
    { const int t = w, v2 = 2 * lane;
      float o0 = 0.f, o1 = 0.f;
#pragma unroll
      for (int q = 0; q < 4; ++q) { const f32x2 p = *(const LAS f32x2*)(LO + (t * 4 + q) * 128 + v2); o0 += p.x; o1 += p.y; }
      const float ss = wave_sum(o0 * o0 + o1 * o1);
      const float rn = __builtin_amdgcn_rsqf(ss * (1.0f / 128.0f) + EPS);
      const unsigned gt = *(const unsigned*)(GBp + (row0 + t) * 512 + h * 128 + v2);
      const f32x2 gw = *(const f32x2*)(INP(I_GNW) + v2);
      *(unsigned*)(MIX + (row0 + t) * DM + DA + h * 128 + v2) = pk2(o0 * rn * gw.x * bflo(gt), o1 * rn * gw.y * bfhi(gt)); }
    LBAR();
}

__device__ __forceinline__ void attn_sample_item(Frame& F, int b, int h) {
    int tid = F.tid; asm volatile("" : "+v"(tid));
    const int lane = tid & 63, t = __builtin_amdgcn_readfirstlane(tid >> 6), g4 = lane >> 4, c = lane & 15;
    const bf16* Qp = WSP(bf16, WS_Q); const bf16* GAp = WSP(bf16, WS_GA); bf16* MIX = WSP(bf16, WS_MIX);
    const float mref = WSP(const float, WS_SCAL)[0];
    const size_t row = (size_t)MP + 8 * b + t;
    const v2u qraw = *(const v2u*)(Qp + row * DA + h * 64 + 4 * c);
    const f32x4 q = {bflo(qraw.x), bfhi(qraw.x), bflo(qraw.y), bfhi(qraw.y)};
    const float* cK = INP(I_CK) + ((size_t)b * WIN * HA + h) * HD + 4 * c; const float* cV = INP(I_CV) + ((size_t)b * WIN * HA + h) * HD + 4 * c;
    const float* nK = F.out + OUT_KNEW + ((size_t)b * ST * HA + h) * HD + 4 * c; const float* nV = F.out + OUT_VNEW + ((size_t)b * ST * HA + h) * HD + 4 * c;
    f32x4 o = {0.f, 0.f, 0.f, 0.f}; float l = 0.f;
#pragma unroll
    for (int di = 0; di < 3; ++di) {
        const int D = di == 0 ? 16 : (di == 1 ? 4 : 1);
#pragma unroll 1
        for (int it0 = 0; it0 < 32; it0 += 4) {
            f32x4 kv[4], vv[4];
#pragma unroll
            for (int u = 0; u < 4; ++u) {
                const int j = 4 * (it0 + u) + g4;
                const int idx = WIN + t - D * j;
                const bool fresh = idx >= WIN;
                const float* kp = fresh ? nK + (size_t)(idx - WIN) * (HA * HD) : cK + (size_t)idx * (HA * HD);
                const float* vp = fresh ? nV + (size_t)(idx - WIN) * (HA * HD) : cV + (size_t)idx * (HA * HD);
                kv[u] = *(const f32x4*)kp; vv[u] = *(const f32x4*)vp;
            }
#pragma unroll
            for (int u = 0; u < 4; ++u) {
                float d = (kv[u][0] * q[0] + kv[u][1] * q[1]) + (kv[u][2] * q[2] + kv[u][3] * q[3]);
                d += __shfl_xor(d, 1); d += __shfl_xor(d, 2); d += __shfl_xor(d, 4); d += __shfl_xor(d, 8);
                const float p = fast_exp2(d - mref);
                l += p; o += vv[u] * p;
            }
        }
        {
            const int idx = WIN + t - D * 128;
            const f32x4 kv = *(const f32x4*)(cK + (size_t)idx * (HA * HD)), vv = *(const f32x4*)(cV + (size_t)idx * (HA * HD));
            float d = (kv[0] * q[0] + kv[1] * q[1]) + (kv[2] * q[2] + kv[3] * q[3]);
            d += __shfl_xor(d, 1); d += __shfl_xor(d, 2); d += __shfl_xor(d, 4); d += __shfl_xor(d, 8);
            const float p = g4 == 0 ? fast_exp2(d - mref) : 0.f;
            l += p; o += vv * p;
        }
    }
#pragma unroll
    for (int j = 0; j < 4; ++j) { o[j] += __shfl_xor(o[j], 16); o[j] += __shfl_xor(o[j], 32); }
    l += __shfl_xor(l, 16); l += __shfl_xor(l, 32);
    if (g4 == 0) {
        const float rl = 1.0f / l;
        const v2u gr = *(const v2u*)(GAp + row * DA + h * 64 + 4 * c);
        v2u w_; w_.x = pk2(o[0] * rl * bflo(gr.x), o[1] * rl * bfhi(gr.x)); w_.y = pk2(o[2] * rl * bflo(gr.y), o[3] * rl * bfhi(gr.y));
        *(v2u*)(MIX + row * DM + h * 64 + 4 * c) = w_;
    }
}
constexpr int N_GLAP = NB * HB, N_ATTS = SB * HA, N_GLAS = SB * HB, N_ATTP = 3 * NB * HA * 4;
constexpr int T_ATTS = N_GLAP, T_GLAS = T_ATTS + N_ATTS, T_ATTP = T_GLAS + N_GLAS, T_TOTAL = T_ATTP + N_ATTP;
constexpr int SLOT_K = 16384, RING_V = 65536;
struct AItem { int b, h, g, x, nsteps; };
struct AStep { int b, h, g, D, r, kb, compute, valid; };
__device__ __forceinline__ AItem aitem_decode(int idx, int var = 0) {
    AItem a; const int bh = idx / 12, sub = idx - 12 * bh; a.g = sub >> 2;
#ifdef PROBE_VARIANTS
    if (var >= 1 && var <= 3) a.g = var - 1;
#endif
    a.b = bh >> 3; a.h = bh & 7; a.x = sub & 3; a.nsteps = 8 + ((a.g == 2 && a.x > 0) ? 1 : 0); return a;
}
__device__ __forceinline__ AStep astep(const AItem& it, int k) {
    AStep s; s.b = it.b; s.h = it.h; s.g = it.g; s.valid = 1; s.compute = 1;
    if (it.g == 0) { s.D = 16; s.r = 4 * it.x + (k >> 1); s.kb = k & 1; }
    else if (it.g == 1) { s.D = 4; s.r = it.x; s.kb = k; }
    else { const int pre = it.x > 0 ? 1 : 0; s.D = 1; s.r = 0; s.kb = 8 * it.x - pre + k; s.compute = (pre && k == 0) ? 0 : 1; }
    return s;
}
__device__ __forceinline__ AStep astep2(const AItem& cur, const AItem& nxt, bool has_nxt, int k_rel) {
    if (k_rel < cur.nsteps) return astep(cur, k_rel);
    if (has_nxt) return astep(nxt, k_rel - cur.nsteps);
    AStep s = astep(cur, 0); s.valid = 0; s.compute = 0; return s;
}
__device__ __forceinline__ void glds16(const void* gsrc, unsigned lds_dst) { unsigned keep;
    asm volatile("s_mov_b32 %0, m0\n\ts_mov_b32 m0, %2\n\ts_nop 0\n\tglobal_load_lds_dwordx4 %1, off\n\ts_mov_b32 m0, %0" : "=&s"(keep) : "v"(gsrc), "s"(lds_dst) : "memory"); }
__device__ __forceinline__ void att_dma_slot(Frame& F, const AStep& st, int slot, int w, int lane) {
    const bf16* Kp = WSP(bf16, WS_K); const bf16* Vp = WSP(bf16, WS_V);
    LAS unsigned char* sb = F.lds + RING_OFF + slot * SLOT_K;
    const size_t rowb = (size_t)st.b * SEQ + st.r; const int m0 = 128 * st.kb;
#pragma unroll
    for (int e = 0; e < 2; ++e) {
        const int key = 16 * w + 8 * e + (lane >> 3), p = lane & 7; const size_t row = rowb + (size_t)(m0 + key) * st.D;
        glds16(Kp + row * DA + st.h * 64 + (p ^ ((key >> 1) & 7)) * 8, (unsigned)__builtin_amdgcn_readfirstlane((int)(unsigned)(__UINTPTR_TYPE__)(sb + (16 * w + 8 * e) * 128)));
        glds16(Vp + row * DA + st.h * 64 + (p ^ (2 * ((key >> 1) & 3))) * 8, (unsigned)__builtin_amdgcn_readfirstlane((int)(unsigned)(__UINTPTR_TYPE__)(sb + RING_V + (16 * w + 8 * e) * 128)));
    }
}
__device__ __forceinline__ int crow(int r, int hi) { return (r & 3) + 8 * (r >> 2) + 4 * hi; }
__device__ __forceinline__ void q_load2(v4u (&q)[2], const bf16* p) {
    asm volatile("global_load_dwordx4 %0, %2, off\n\tglobal_load_dwordx4 %1, %2, off offset:64" : "=&v"(q[0]), "=&v"(q[1]) : "v"(p) : "memory");
}
#define WAITV_CASE(n) case n: asm volatile("s_waitcnt vmcnt(" #n ")" : "+v"(dep) :: "memory"); break;
__device__ __forceinline__ void wait_vm(int n, unsigned& dep) {
    switch (n) { WAITV_CASE(2) WAITV_CASE(3) WAITV_CASE(4) WAITV_CASE(5) WAITV_CASE(6) WAITV_CASE(7) WAITV_CASE(8) WAITV_CASE(9) WAITV_CASE(10) WAITV_CASE(11) default: asm volatile("s_waitcnt vmcnt(0)" : "+v"(dep) :: "memory"); }
}
template <bool FIRST, bool WRAP>
__device__ __forceinline__ void att_compute(const LAS unsigned char* ring, int prev, const bf16x8 (&qf)[2], float mref, int qw, int lane, f32x4 (&o)[4], f32x4& lacc, int pv = 0) {
    const int ql = lane & 15, g = lane >> 4, i16 = lane & 15;
    const int ksw = (ql >> 1) & 7;
    const int koff0 = ql * 128 + ((g ^ ksw) * 16), koff1 = ql * 128 + (((4 + g) ^ ksw) * 16);
    const int vrowl = 4 * g + (i16 >> 2), vsw = 2 * ((vrowl >> 1) & 3), vpc = (i16 & 3) >> 1;
    const int voff = vrowl * 128 + (i16 & 1) * 8;
#define ATT_ROWB(kw) (WRAP ? ((((kw) < 128) ? 3 * 128 + (kw) : (kw) - 128) * 128) : ((prev * 128 + (kw)) * 128))
    const LAS unsigned char* kb0 = ring + koff0; const LAS unsigned char* kb1 = ring + koff1; const LAS unsigned char* vb = ring + RING_V + voff;
    const LAS unsigned char* vbd[4];
#pragma unroll
    for (int dt = 0; dt < 4; ++dt) vbd[dt] = vb + (((2 * dt + vpc) ^ vsw) * 16);
    const int wb = WRAP ? 0 : (prev * 128 + 16 * qw) * 128;
    f32x4 st[9];
#pragma unroll
    for (int t = 0; t < 9; ++t) {
        const int rb = WRAP ? ATT_ROWB(16 * (qw + t)) : wb + t * 2048;
        const bf16x8 a0 = *(const LAS bf16x8*)(kb0 + rb), a1 = *(const LAS bf16x8*)(kb1 + rb);
        f32x4 c = {-mref, -mref, -mref, -mref};
        c = MFMA16(a0, qf[0], c); st[t] = MFMA16(a1, qf[1], c);
    }
    s16x4 va[2][4][2];
#define ATT_VLOAD(u, buf) do { const int r0_ = WRAP ? ATT_ROWB(16 * (qw + 2 * (u))) : wb + 2 * (u) * 2048; \
        const int r1_ = ((u) < 4) ? (WRAP ? ATT_ROWB(16 * (qw + 2 * (u) + 1)) : wb + (2 * (u) + 1) * 2048) : r0_; \
        _Pragma("unroll") for (int dt = 0; dt < 4; ++dt) { va[buf][dt][0] = tr16(vbd[dt] + r0_); va[buf][dt][1] = tr16(vbd[dt] + r1_); } } while (0)
    ATT_VLOAD(0, 0);
#pragma unroll
    for (int t = 0; t < 9; ++t) {
#pragma unroll
        for (int r = 0; r < 4; ++r) {
            float p = fast_exp2(st[t][r]);
            if (t == 0) { if (4 * g + r < ql) p = 0.f; }
            if (t == 8) { if (4 * g + r > ql) p = 0.f; }
            if (FIRST) { if (qw + t < 8) p = 0.f; }
            st[t][r] = p;
        }
    }
    const v4u one4 = {0x3F803F80u, 0x3F803F80u, 0x3F803F80u, 0x3F803F80u}; const bf16x8 ones = __builtin_bit_cast(bf16x8, one4);
#pragma unroll
    for (int u = 0; u < 5; ++u) {
        if (u < 4) ATT_VLOAD(u + 1, (u + 1) & 1);
        __builtin_amdgcn_sched_barrier(0);
        const f32x4 z = {0.f, 0.f, 0.f, 0.f};
        const bf16x8 pb = pk8(st[2 * u], (u < 4) ? st[2 * u + 1] : z);
#pragma unroll
        for (int dt = 0; dt < 4; ++dt) o[dt] = MFMA16(cat8(va[u & 1][dt][0], va[u & 1][dt][1]), pb, o[dt]);
        lacc = MFMA16(ones, pb, lacc);
        __builtin_amdgcn_sched_barrier(0);
    }
#undef ATT_VLOAD
#undef ATT_ROWB
}
__device__ __forceinline__ void att_q_dma(Frame& F, const AStep& st, int w, int lane) {
    const bf16* Qp = WSP(bf16, WS_Q);
    LAS unsigned char* T = F.lds + OSTAGE_OFF + w * 2048;
#pragma unroll
    for (int e = 0; e < 2; ++e) {
        const int rr = lane >> 3, q = 16 * w + 8 * e + rr, p = (lane & 7) ^ rr;
        const size_t row = (size_t)st.b * SEQ + (size_t)(128 * st.kb + q) * st.D + st.r;
        glds16(Qp + row * DA + st.h * 64 + p * 8, (unsigned)__builtin_amdgcn_readfirstlane((int)(unsigned)(__UINTPTR_TYPE__)(T + e * 1024)));
    }
}
__device__ __forceinline__ void attn_prompt_loop(Frame& F, int t) {
    int tid_ = F.tid; asm volatile("" : "+v"(tid_));
    const int lane = tid_ & 63, w = __builtin_amdgcn_readfirstlane(tid_ >> 6), ql = lane & 15, g4 = lane >> 4;
    bf16* OP = WSP(bf16, WS_OPART); float* LP = WSP(float, WS_LPART);
    const float mref = WSP(const float, WS_SCAL)[0];
    const LAS unsigned char* L = F.lds + RING_OFF;
    LAS unsigned char* stg = F.lds + OSTAGE_OFF + w * 2048;
    const int qoff0 = ql * 128 + ((g4 ^ (ql & 7)) << 4), qoff1 = ql * 128 + (((4 + g4) ^ (ql & 7)) << 4);
    { LAS v4u* z = (LAS v4u*)(F.lds + RING_OFF + RING_V + 3 * SLOT_K); z[tid_] = (v4u){0u, 0u, 0u, 0u}; z[tid_ + 512] = (v4u){0u, 0u, 0u, 0u}; }
    const int avar = F.item_mask >> 8;
    AItem cur = aitem_decode(t - T_ATTP, avar), nxt = cur; bool has_nxt = false;
    int k = 0, sc = 0;
    AStep st = astep(cur, 0);
    att_q_dma(F, st, w, lane);
    att_dma_slot(F, st, 0, w, lane);
    const AStep s1 = astep(cur, 1);
    att_dma_slot(F, s1, 1, w, lane);
    unsigned dep0 = 0u;
    wait_vm(8, dep0);
    v4u qn[2]; qn[0] = *(const LAS v4u*)(stg + qoff0); qn[1] = *(const LAS v4u*)(stg + qoff1);
    LDS_WAIT();
    att_q_dma(F, s1, w, lane);
    bool d0 = true, d1 = true, first = true, h2 = false;
    unsigned tkt = 0u;
    v4u ost[2] = {}; float lst = 0.f; bf16* ostp = nullptr; float* lstp = nullptr; bool have_st = false;
    for (;;) {
        if (first) wait_vm(6, dep0); else wait_vm((d0 ? 2 : 0) + (d1 ? 6 : 0) + (h2 ? 3 : 0), dep0);
        LBAR();
        first = false;
        const bool h1 = have_st;
        if (have_st) {
            *(v4u*)(ostp) = ost[0]; *(v4u*)(ostp + 32) = ost[1];
            if (g4 == 0) *lstp = lst;
            have_st = false;
        }
        if (k == 0 && tid_ == 0) { const unsigned one_ = 1u; asm volatile("global_atomic_add %0, %1, %2, off sc0" : "=&v"(tkt) : "v"(F.ctl + CW_TICKET), "v"(one_) : "memory"); }
        if (k == 2 && tid_ == 0) { asm volatile("" : "+v"(tkt)); F.MISC[4] = tkt; }
        if (k == 3) { const int tn = __builtin_amdgcn_readfirstlane((int)F.MISC[4]); has_nxt = tn < T_TOTAL; if (has_nxt) nxt = aitem_decode(tn - T_ATTP, avar); }
        const AStep s2 = astep2(cur, nxt, has_nxt, k + 2);
        const bool d2 = s2.valid != 0;
        if (d2) att_dma_slot(F, s2, (sc + 2) & 3, w, lane);
        bf16x8 qf[2];
#pragma unroll
        for (int d0_ = 0; d0_ < 2; ++d0_) qf[d0_] = __builtin_bit_cast(bf16x8, qn[d0_]);
        f32x4 o[4]; f32x4 lacc = {0.f, 0.f, 0.f, 0.f};
#pragma unroll
        for (int dt = 0; dt < 4; ++dt) o[dt] = (f32x4){0.f, 0.f, 0.f, 0.f};
        if (st.compute) {
            const int prev = (sc + 3) & 3;
            if (prev == 3) { if (st.kb == 0) att_compute<true, true>(L, prev, qf, mref, w, lane, o, lacc, avar); else att_compute<false, true>(L, prev, qf, mref, w, lane, o, lacc, avar); }
            else { if (st.kb == 0) att_compute<true, false>(L, prev, qf, mref, w, lane, o, lacc, avar); else att_compute<false, false>(L, prev, qf, mref, w, lane, o, lacc, avar); }
        }
        { unsigned dp = __builtin_bit_cast(unsigned, lacc[0]); wait_vm((d2 ? 4 : 0) + (h1 ? 3 : 0), dp); lacc[0] = __builtin_bit_cast(float, dp); }
        qn[0] = *(const LAS v4u*)(stg + qoff0); qn[1] = *(const LAS v4u*)(stg + qoff1);
        if (st.compute) {
#pragma unroll
            for (int u = 0; u < 4; ++u) { v2u x; x.x = pk2(o[u][0], o[u][1]); x.y = pk2(o[u][2], o[u][3]); *(LAS v2u*)(stg + ql * 128 + (16 * u + 4 * g4) * 2) = x; }
            LDS_WAIT();
            const int sq = lane >> 2, sp = lane & 3;
            ost[0] = *(const LAS v4u*)(stg + sq * 128 + sp * 16); ost[1] = *(const LAS v4u*)(stg + sq * 128 + 64 + sp * 16);
            const size_t qrow = (size_t)st.b * SEQ + (size_t)(128 * st.kb + 16 * w + sq) * st.D + st.r;
            ostp = OP + (size_t)st.g * OPART_STRIDE + qrow * DA + st.h * 64 + sp * 8;
            const size_t lrow = (size_t)st.b * SEQ + (size_t)(128 * st.kb + 16 * w + ql) * st.D + st.r;
            lstp = LP + (size_t)st.g * LPART_STRIDE + lrow * HA + st.h;
            lst = lacc[0];
            have_st = true;
        }
        LDS_WAIT();
        if (d2) att_q_dma(F, s2, w, lane);
        ++sc; ++k; d0 = d1; d1 = d2; h2 = h1;
        if (k == cur.nsteps) { if (!has_nxt) break; cur = nxt; has_nxt = false; k = 0; }
        st = astep(cur, k);
    }
    if (have_st) {
        *(v4u*)(ostp) = ost[0]; *(v4u*)(ostp + 32) = ost[1];
        if (g4 == 0) *lstp = lst;
    }
    VM_WAIT(); LBAR();
}
__device__ __forceinline__ int p2_fetch(Frame& F) {
    if (F.tid == 0) F.MISC[4] = __hip_atomic_fetch_add(F.ctl + CW_TICKET, 1u, RLX_AGENT);
    LBAR(); const int t = __builtin_amdgcn_readfirstlane((int)F.MISC[4]); LBAR(); return t;
}
__device__ __forceinline__ void p2_phase(Frame& F) {
    int t = p2_fetch(F);
    while (t < T_TOTAL) {
#ifndef ONLY_ITEM
#define ONLY_ITEM -1
#endif
        if (t < T_ATTS) { if ((ONLY_ITEM < 0 || ONLY_ITEM == 0) && (F.item_mask & 1)) gla_prompt_item(F, t >> 2, t & 3); }
        else if (t < T_GLAS) { const int i = t - T_ATTS; if ((ONLY_ITEM < 0 || ONLY_ITEM == 1) && (F.item_mask & 2)) attn_sample_item(F, i >> 3, i & 7); }
        else if (t < T_ATTP) { const int i = t - T_GLAS; if ((ONLY_ITEM < 0 || ONLY_ITEM == 2) && (F.item_mask & 4)) gla_sample_item(F, i >> 2, i & 3); }
        else { if ((ONLY_ITEM < 0 || ONLY_ITEM == 3) && (F.item_mask & 8)) attn_prompt_loop(F, t); break; }
        t = p2_fetch(F);
    }
}
struct OneUnit { int pm, pn;
    __device__ __forceinline__ bool next(int i, pg8::Unit& u) const { if (i > 0) return false; u.pm = pm; u.pn = pn; return true; }
    __device__ __forceinline__ void a_ready(const pg8::Unit&) const {}
    __device__ __forceinline__ void done(const pg8::Unit&) const {} };
constexpr int N_SU_IN = (MS / 256) * (NIN / 256), N_SU_OUT = (MS / 256) * (DM / 256);
__device__ __forceinline__ void p2b_combine(Frame& F) {
    const bf16* OP = WSP(bf16, WS_OPART); const float* LP = WSP(float, WS_LPART); const bf16* GAp = WSP(bf16, WS_GA); bf16* MIX = WSP(bf16, WS_MIX);
    const size_t gt = (size_t)(blockIdx.x - N_SU_OUT) * (NWAVES * 64) + F.tid, NGT = (size_t)(F.G - N_SU_OUT) * NWAVES * 64;
    constexpr size_t NIT = (size_t)MP * 64;
    for (size_t it = gt; it < NIT; it += 2 * NGT) {
        const size_t itb = it + NGT; const bool hasb = itb < NIT; const size_t i2 = hasb ? itb : it;
        const size_t tok[2] = {it >> 6, i2 >> 6}; const int c8[2] = {(int)(it & 63), (int)(i2 & 63)};
        v4u x[2][3], gx[2]; float lv[2][3];
#pragma unroll
        for (int e = 0; e < 2; ++e) {
#pragma unroll
            for (int g = 0; g < 3; ++g) { x[e][g] = *(const v4u*)(OP + (size_t)g * OPART_STRIDE + tok[e] * DA + 8 * c8[e]); lv[e][g] = LP[(size_t)g * LPART_STRIDE + tok[e] * HA + (c8[e] >> 3)]; }
            gx[e] = *(const v4u*)(GAp + tok[e] * DA + 8 * c8[e]);
        }
#pragma unroll
        for (int e = 0; e < 2; ++e) {
            if (e == 1 && !hasb) continue;
            f32x4 a = {0.f, 0.f, 0.f, 0.f}, b = {0.f, 0.f, 0.f, 0.f}; float l = 0.f;
#pragma unroll
            for (int g = 0; g < 3; ++g) { a += (f32x4){bflo(x[e][g].x), bfhi(x[e][g].x), bflo(x[e][g].y), bfhi(x[e][g].y)}; b += (f32x4){bflo(x[e][g].z), bfhi(x[e][g].z), bflo(x[e][g].w), bfhi(x[e][g].w)}; l += lv[e][g]; }
            const float rl = 1.0f / l;
            a = a * rl * (f32x4){bflo(gx[e].x), bfhi(gx[e].x), bflo(gx[e].y), bfhi(gx[e].y)}; b = b * rl * (f32x4){bflo(gx[e].z), bfhi(gx[e].z), bflo(gx[e].w), bfhi(gx[e].w)};
            *(v4u*)(MIX + tok[e] * DM + 8 * c8[e]) = pack8(a, b);
        }
    }
}

__device__ __forceinline__ void stagger_start(int c, int n_long, int G, unsigned span_ticks) {
    if (c < n_long || span_ticks == 0u) return;
    const unsigned frac = (unsigned)(((c - n_long) * 97) % (G - n_long));
    const unsigned long long wait = (unsigned long long)span_ticks * frac / (unsigned)(G - n_long), t0 = __builtin_amdgcn_s_memrealtime();
    while (__builtin_amdgcn_s_memrealtime() - t0 < wait) __builtin_amdgcn_s_sleep(16);
}
#ifndef STAG1
#define STAG1 0
#endif
#ifndef STAG3
#define STAG3 0
#endif
#ifndef MK_N_LAUNCHES
#define MK_N_LAUNCHES 6
#endif
constexpr int N_PHASES = 6;
__global__ void __launch_bounds__(NWAVES * 64, 2) hymba_fwd(Args args) {
    extern __shared__ __attribute__((aligned(16))) unsigned char lds[];
    Frame F;
    F.lds = (LAS unsigned char*)lds; F.MISC = (volatile LAS unsigned*)(F.lds + MISC_OFF);
    F.tid = threadIdx.x; F.lane = F.tid & 63; F.wave = __builtin_amdgcn_readfirstlane(F.tid >> 6); F.G = gridDim.x;
    F.item_mask = args.item_mask; F.ws = args.ws; F.ctl = (gu32*)(args.ws + WS_CTL); F.out = args.out;
    for (int u = F.tid; u < (LDS_BYTES - LDSCTL_OFF) / 4; u += NWAVES * 64) ((LAS unsigned*)(F.lds + LDSCTL_OFF))[u] = 0u;
    __syncthreads();
    const int lo = args.ph_lo, hi = args.ph_hi;
    XcdBarrier bar; bar.bar = (unsigned*)(F.ctl + CW_BAR); bar.x = 0; bar.st = nullptr;
    if (hi - lo > 1) bar = xcd_barrier_post((unsigned*)(F.ctl + CW_BAR), F.MISC + 8);
#ifdef ONLY_PHASE
#define IN(k) ((k) == ONLY_PHASE && lo <= (k) && (k) < hi)
#else
#define IN(k) (lo <= (k) && (k) < hi)
#endif
#define BOTH(k) (IN(k) && IN((k) + 1))
    if (IN(0)) {
        p0_prologue(F);
        asm volatile("s_waitcnt vmcnt(0)" ::: "memory"); __syncthreads();
        if (F.tid == 0) { __builtin_amdgcn_fence(__ATOMIC_RELEASE, "agent"); asm volatile("s_waitcnt vmcnt(0)" ::: "memory"); __hip_atomic_fetch_add(F.ctl + CW_P0A, 1u, RLX_AGENT); }
        if (!IN(1) && BOTH(0)) xcd_barrier(bar);
    }
    if (IN(1)) {
        if ((int)blockIdx.x < N_SU_IN) {
            if (IN(0)) {
                if (F.tid == 0) {
                    unsigned sp = 0; bool ok = true;
                    while (__hip_atomic_load(F.ctl + CW_P0A, RLX_AGENT) < (unsigned)F.G) { __builtin_amdgcn_s_sleep(8); if (++sp > (1u << 22)) { ok = false; break; } }
                    if (!ok) __hip_atomic_store(F.ctl + CW_TMO, 1u, RLX_AGENT);
                    __builtin_amdgcn_fence(__ATOMIC_ACQUIRE, "agent"); asm volatile("s_waitcnt vmcnt(0)" ::: "memory");
                }
                __syncthreads();
                __builtin_amdgcn_fence(__ATOMIC_ACQUIRE, "agent"); asm volatile("s_waitcnt vmcnt(0)" ::: "memory");
            }
            pg8::Gemm g{WSP(const pg8::bf16_t, WS_XB), WSP(const pg8::bf16_t, WS_WIN), MTOT, NIN, DM}; OneUnit S{MP / 256 + (int)blockIdx.x / (NIN / 256), (int)blockIdx.x % (NIN / 256)};
            EpiIn E{WSP(const float, WS_RSTD), WSP(const float, WS_ROPE), WSP(const float, WS_SCAL) + 64, INP(I_BGATE), F.ws, F.out, F.lds + OSTAGE_OFF};
            pg8::gemm_phase<EpiIn, OneUnit, false, true>(F.lds + RING_OFF, g, S, E);
        }
        p0b_convert(F);
        if (BOTH(1)) xcd_barrier(bar);
    }
    if (IN(2)) {
        pg8::Gemm g{WSP(const pg8::bf16_t, WS_XB), WSP(const pg8::bf16_t, WS_WIN), MP, NIN, DM}; pg8::StaticOrder S; S.init(MP, NIN, F.G, (int)blockIdx.x);
        EpiIn E{WSP(const float, WS_RSTD), WSP(const float, WS_ROPE), WSP(const float, WS_SCAL) + 64, INP(I_BGATE), F.ws, F.out, F.lds + OSTAGE_OFF};
        stagger_start((int)blockIdx.x, (MP / 256) * (NIN / 256) % F.G, F.G, STAG1);
        pg8::gemm_phase<EpiIn, pg8::StaticOrder, true, true>(F.lds + RING_OFF, g, S, E);
        if (BOTH(2)) xcd_barrier(bar);
    }
    if (IN(3)) { p2_phase(F); if (BOTH(3)) xcd_barrier(bar); }
    if (IN(4)) {
        if ((int)blockIdx.x < N_SU_OUT) {
            pg8::Gemm g{WSP(const pg8::bf16_t, WS_MIX), WSP(const pg8::bf16_t, WS_WOUT), MTOT, DM, DM}; OneUnit S{MP / 256 + (int)blockIdx.x / (DM / 256), (int)blockIdx.x % (DM / 256)};
            EpiOut E{WSP(const bf16, WS_XB), F.out, F.lds + OSTAGE_OFF};
            pg8::gemm_phase<EpiOut, OneUnit, false, true>(F.lds + RING_OFF, g, S, E);
        } else p2b_combine(F);
        if (BOTH(4)) xcd_barrier(bar);
    }
    if (IN(5)) {
        pg8::Gemm g{WSP(const pg8::bf16_t, WS_MIX), WSP(const pg8::bf16_t, WS_WOUT), MP, DM, DM}; pg8::StaticOrder S; S.init(MP, DM, F.G, (int)blockIdx.x);
        EpiOut E{WSP(const bf16, WS_XB), F.out, F.lds + OSTAGE_OFF};
        stagger_start((int)blockIdx.x, (MP / 256) * (DM / 256) % F.G, F.G, STAG3);
        pg8::gemm_phase<EpiOut, pg8::StaticOrder, true, true>(F.lds + RING_OFF, g, S, E);
    }
#undef IN
#undef BOTH
}

extern "C" void kernel_launch(void* const* d_in, const int* in_sizes, int n_in, void* d_out, int out_size, void* d_ws, size_t ws_size, hipStream_t stream) {
    static int grid = 0;
    if (grid == 0) {
        if (n_in != 13 || (size_t)out_size != OUT_END || ws_size < WS_END) { fprintf(stderr, "kernel_launch: unexpected shapes (n_in %d out %d ws %zu)\n", n_in, out_size, ws_size); grid = -1; return; }
        int dev = 0, cus = 0, per_cu = 0;
        if (hipGetDevice(&dev) != hipSuccess || hipDeviceGetAttribute(&cus, hipDeviceAttributeMultiprocessorCount, dev) != hipSuccess) { grid = -1; return; }
        if (hipFuncSetAttribute((const void*)hymba_fwd, hipFuncAttributeMaxDynamicSharedMemorySize, LDS_BYTES) != hipSuccess) { fprintf(stderr, "kernel_launch: hipFuncSetAttribute failed\n"); grid = -1; return; }
        if (hipOccupancyMaxActiveBlocksPerMultiprocessor(&per_cu, (const void*)hymba_fwd, NWAVES * 64, LDS_BYTES) != hipSuccess || per_cu < 1) fprintf(stderr, "kernel_launch: occupancy query reports %d\n", per_cu);
        (void)hipGetLastError();
        grid = cus;
    }
    if (grid < 0) return;
    if (hipMemsetAsync((char*)d_ws + WS_CTL, 0, CTL_ZERO_BYTES, stream) != hipSuccess) return;
    Args a{};
    for (int i = 0; i < 13; ++i) a.in[i] = (const float*)d_in[i];
    a.out = (float*)d_out; a.ws = (unsigned char*)d_ws; a.item_mask = 15;
    constexpr int NL = MK_N_LAUNCHES;
    static_assert(NL == 1 || NL == N_PHASES, "MK_N_LAUNCHES is 1 or 6");
    for (int li = 0; li < NL; ++li) {
        a.ph_lo = (NL == 1) ? 0 : li; a.ph_hi = (NL == 1) ? N_PHASES : li + 1;
        hipLaunchKernelGGL(hymba_fwd, dim3(grid), dim3(NWAVES * 64), LDS_BYTES, stream, a);
        const hipError_t le = hipPeekAtLastError();
        if (le != hipSuccess) { fprintf(stderr, "kernel_launch: launch %d failed: %s\n", li, hipGetErrorName(le)); break; }
    }
#ifdef PROBE_EXTRA_PHASE
    (void)hipMemsetAsync((char*)d_ws + WS_CTL, 0, CTL_ZERO_BYTES, stream);
    a.ph_lo = PROBE_EXTRA_PHASE; a.ph_hi = PROBE_EXTRA_PHASE + 1;
#ifdef PROBE_ITEM_MASK
    a.item_mask = PROBE_ITEM_MASK;
#endif
    hipLaunchKernelGGL(hymba_fwd, dim3(grid), dim3(NWAVES * 64), LDS_BYTES, stream, a);
#endif
}
```

```cpp
#include <hip/hip_runtime.h>
#include <cstdio>
#include <cstdint>
#include <cmath>
#define MK_N_LAUNCHES 1
namespace pg8 {
#define PG8_LAS __attribute__((address_space(3)))
typedef unsigned short bf16_t;
typedef short bf16x8 __attribute__((ext_vector_type(8)));
typedef float f32x4 __attribute__((ext_vector_type(4)));
typedef unsigned u32x4 __attribute__((ext_vector_type(4)));
constexpr int BM = 256, BK = 64, HALF = 128, HTB = HALF * BK * 2  , STAGE_BYTES = 8 * HTB, NXCD = 8, WGM = 8;

__host__ __device__ __forceinline__ int lds_byte(int r, int c) { const int st = (r >> 4) * 2 + (c >> 5), rr = r & 15, cc = c & 31, ob = rr * 64 + cc * 2; return st * 1024 + (ob ^ (((ob >> 9) & 1) << 5)); }
__host__ __device__ __forceinline__ void stage_rc(int b, int& R, int& C) { const int st = b / 1024, sb = b % 1024, swz = sb ^ (((sb >> 9) & 1) << 5); R = (st >> 1) * 16 + swz / 64; C = (st & 1) * 32 + (swz % 64) / 2; }
__host__ __device__ __forceinline__ int perm32(int rho) { const int n = rho >> 4, i = rho & 15; return 8 * (i >> 2) + 4 * n + (i & 3); }

struct Unit { int pm, pn; };
struct Gemm { const bf16_t* A; const bf16_t* Bt; int M, N, K; };

struct StaticOrder {
    int nM, nN, nwg, G, c;
    __host__ __device__ void init(int M, int N, int G_, int c_) { nM = M / BM; nN = N / BM; nwg = nM * nN; G = G_; c = c_; }
    __host__ __device__ bool next(int i, Unit& u) const {
        const long L = (long)i * G + c; if (L >= nwg) return false;
        int wgid = (int)L; { const int q = nwg / NXCD, r = nwg % NXCD, xcd = wgid % NXCD, off = wgid / NXCD; wgid = (xcd < r ? xcd * (q + 1) : r * (q + 1) + (xcd - r) * q) + off; }
        const int nig = WGM * nN, gid = wgid / nig, fm = gid * WGM, gsz = (nM - fm) < WGM ? (nM - fm) : WGM;
        u.pm = fm + ((wgid % nig) % gsz); u.pn = (wgid % nig) / gsz; return true;
    }
    __device__ __forceinline__ void a_ready(const Unit&) const {}
    __device__ __forceinline__ void done(const Unit&) const {}
};

__device__ __forceinline__ unsigned cvt_pk_bf16(float lo, float hi) { unsigned r; asm volatile("v_cvt_pk_bf16_f32 %0, %1, %2" : "=v"(r) : "v"(lo), "v"(hi)); return r; }
template <class Epi, class Sched, bool ALIGN_EPI = false, bool SP2 = false>
__device__ __forceinline__ void gemm_phase(PG8_LAS unsigned char* lds, const Gemm g, const Sched& S, const Epi& E) {
    const int tid = threadIdx.x, wid = __builtin_amdgcn_readfirstlane(tid >> 6), lane = tid & 63, wr = wid >> 2, wc = wid & 3, fr = lane & 15, fq = lane >> 4;
    const int K = g.K, nt = K / BK;
    unsigned voffA[2], voffB[2];
#pragma unroll
    for (int i = 0; i < 2; ++i) { int R, C; stage_rc(tid * 16 + i * 8192, R, C); const int Rb = Epi::PERM ? ((R & ~31) + perm32(R & 31)) : R;
        voffA[i] = (unsigned)(R * K + C) * 2u; voffB[i] = (unsigned)(Rb * K + C) * 2u; }
    const size_t kstep = (size_t)(BK * 2);
    const size_t hstep = (size_t)HALF * K * 2;
    const size_t tstep = 2 * hstep;
    const unsigned ldsw = (unsigned)wid * 1024u;
    const int aoff = lds_byte(wr * 64 + fr, fq * 8), boff = lds_byte(wc * 32 + fr, fq * 8);
#define PG8_SA(b, h) (((b) * 2 + (h)) * HTB)
#define PG8_SB(b, h) ((4 + (b) * 2 + (h)) * HTB)
#define PG8_STAGE(bufoff, gbase, voff) do { _Pragma("unroll") for (int _i = 0; _i < 2; ++_i) \
        __builtin_amdgcn_global_load_lds((const unsigned*)((const char*)(gbase) + (voff)[_i]), (PG8_LAS unsigned*)(lds + (bufoff) + ldsw + _i * 8192), 16, 0, 0); } while (0)
#define PG8_LDA(dst, b, h) do { _Pragma("unroll") for (int m = 0; m < 4; ++m) _Pragma("unroll") for (int k = 0; k < 2; ++k) dst[m][k] = *(const PG8_LAS bf16x8*)(lds + PG8_SA(b, h) + aoff + m * 2048 + k * 1024); } while (0)
#define PG8_LDB(dst, b, h) do { _Pragma("unroll") for (int n = 0; n < 2; ++n) _Pragma("unroll") for (int k = 0; k < 2; ++k) dst[n][k] = *(const PG8_LAS bf16x8*)(lds + PG8_SB(b, h) + boff + n * 2048 + k * 1024); } while (0)
#define PG8_MMA(ai, bj, At, Bt) do { __builtin_amdgcn_s_setprio(1); _Pragma("unroll") for (int m = 0; m < 4; ++m) _Pragma("unroll") for (int n = 0; n < 2; ++n) _Pragma("unroll") for (int k = 0; k < 2; ++k) \
        acc[ai][bj][m][n] = __builtin_amdgcn_mfma_f32_16x16x32_bf16(Bt[n][k], At[m][k], acc[ai][bj][m][n], 0, 0, 0); __builtin_amdgcn_s_setprio(0); } while (0)
#define PG8_WAIT_V(n) asm volatile("s_waitcnt vmcnt(" #n ")" ::: "memory")
#define PG8_WAIT_L(n) asm volatile("s_waitcnt lgkmcnt(" #n ")" ::: "memory")
#define PG8_BAR __builtin_amdgcn_s_barrier()
#define PG8_SCHED __builtin_amdgcn_sched_barrier(0)
    Unit cur, nxt; int ui = 0;
    if (!S.next(0, cur)) return;
    f32x4 acc[2][2][4][2];
#pragma unroll
    for (int a = 0; a < 2; ++a)
#pragma unroll
        for (int b = 0; b < 2; ++b)
#pragma unroll
            for (int m = 0; m < 4; ++m)
#pragma unroll
                for (int n = 0; n < 2; ++n) acc[a][b][m][n] = (f32x4){0.f, 0.f, 0.f, 0.f};
    bf16x8 At[4][2], B0[2][2], B1[2][2];
    const char* cA = (const char*)g.A + (size_t)cur.pm * tstep; const char* cB = (const char*)g.Bt + (size_t)cur.pn * tstep;
    S.a_ready(cur);
    if constexpr (SP2) {
        PG8_STAGE(PG8_SB(0, 0), cB, voffB); PG8_STAGE(PG8_SB(0, 1), cB + hstep, voffB); PG8_STAGE(PG8_SA(0, 0), cA, voffA); PG8_STAGE(PG8_SA(0, 1), cA + hstep, voffA);
        if (wr == 1) PG8_BAR;
        PG8_WAIT_V(2); PG8_BAR;
        PG8_STAGE(PG8_SB(1, 0), cB + kstep, voffB); PG8_STAGE(PG8_SA(1, 0), cA + kstep, voffA); PG8_STAGE(PG8_SB(1, 1), cB + hstep + kstep, voffB);
        PG8_WAIT_V(6); PG8_BAR;
    } else {
        PG8_STAGE(PG8_SB(0, 0), cB, voffB); PG8_STAGE(PG8_SA(0, 0), cA, voffA); PG8_STAGE(PG8_SB(0, 1), cB + hstep, voffB); PG8_STAGE(PG8_SA(0, 1), cA + hstep, voffA);
        if (wr == 1) PG8_BAR;
        PG8_WAIT_V(4); PG8_BAR;
        PG8_STAGE(PG8_SB(1, 0), cB + kstep, voffB); PG8_STAGE(PG8_SA(1, 0), cA + kstep, voffA); PG8_STAGE(PG8_SB(1, 1), cB + hstep + kstep, voffB);
        PG8_WAIT_V(6); PG8_BAR;
    }
    for (;;) {
        const bool has_next = S.next(ui + 1, nxt);
        const char* nA = has_next ? (const char*)g.A + (size_t)nxt.pm * tstep : cA; const char* nB = has_next ? (const char*)g.Bt + (size_t)nxt.pn * tstep : cB;
        for (int t = 0; t < nt; t += 2) {
            const bool last = (t == nt - 2);
            const char* a1 = cA + (size_t)(t + 1) * kstep;
            const char* a2 = last ? nA : cA + (size_t)(t + 2) * kstep; const char* b2 = last ? nB : cB + (size_t)(t + 2) * kstep;
            const char* a3 = a2 + kstep; const char* b3 = b2 + kstep;
            if (last && has_next) S.a_ready(nxt);
            if constexpr (SP2) {
            PG8_LDB(B0, 0, 0); PG8_LDB(B1, 0, 1); PG8_SCHED; PG8_LDA(At, 0, 0); PG8_STAGE(PG8_SA(1, 1), a1 + hstep, voffA);
            PG8_WAIT_V(8); PG8_WAIT_L(0); PG8_BAR; PG8_MMA(0, 0, At, B0); PG8_MMA(0, 1, At, B1); PG8_BAR; PG8_SCHED;
            PG8_LDA(At, 0, 1); PG8_STAGE(PG8_SB(0, 0), b2, voffB); PG8_STAGE(PG8_SB(0, 1), b2 + hstep, voffB); PG8_STAGE(PG8_SA(0, 0), a2, voffA);
            PG8_WAIT_V(8); PG8_WAIT_L(0); PG8_BAR; PG8_MMA(1, 0, At, B0); PG8_MMA(1, 1, At, B1); PG8_BAR; PG8_SCHED;
            PG8_LDB(B0, 1, 0); PG8_LDB(B1, 1, 1); PG8_SCHED; PG8_LDA(At, 1, 0); PG8_STAGE(PG8_SA(0, 1), a2 + hstep, voffA);
            PG8_WAIT_V(8); PG8_WAIT_L(0); PG8_BAR; PG8_MMA(0, 0, At, B0); PG8_MMA(0, 1, At, B1); PG8_BAR; PG8_SCHED;
            PG8_LDA(At, 1, 1); PG8_STAGE(PG8_SB(1, 0), b3, voffB); PG8_STAGE(PG8_SB(1, 1), b3 + hstep, voffB); PG8_STAGE(PG8_SA(1, 0), a3, voffA);
            PG8_WAIT_V(8); PG8_WAIT_L(0); PG8_BAR; PG8_MMA(1, 0, At, B0); PG8_MMA(1, 1, At, B1); PG8_BAR; PG8_SCHED;
            } else {
            PG8_LDB(B0, 0, 0); PG8_SCHED; PG8_LDA(At, 0, 0); PG8_STAGE(PG8_SA(1, 1), a1 + hstep, voffA);
            PG8_WAIT_L(8); PG8_BAR; PG8_WAIT_L(0); PG8_MMA(0, 0, At, B0); PG8_BAR; PG8_SCHED;
            PG8_LDB(B1, 0, 1); PG8_STAGE(PG8_SB(0, 0), b2, voffB);
            PG8_BAR; PG8_WAIT_L(0); PG8_MMA(0, 1, At, B1); PG8_BAR;
            PG8_LDA(At, 0, 1); PG8_STAGE(PG8_SA(0, 0), a2, voffA);
            PG8_BAR; PG8_WAIT_L(0); PG8_MMA(1, 0, At, B0); PG8_BAR; PG8_SCHED;
            PG8_STAGE(PG8_SB(0, 1), b2 + hstep, voffB);
            PG8_WAIT_V(6); PG8_BAR; PG8_MMA(1, 1, At, B1); PG8_BAR;
            PG8_LDB(B0, 1, 0); PG8_SCHED; PG8_LDA(At, 1, 0); PG8_STAGE(PG8_SA(0, 1), a2 + hstep, voffA);
            PG8_WAIT_L(8); PG8_BAR; PG8_WAIT_L(0); PG8_MMA(0, 0, At, B0); PG8_BAR; PG8_SCHED;
            PG8_LDB(B1, 1, 1); PG8_STAGE(PG8_SB(1, 0), b3, voffB);
            PG8_BAR; PG8_WAIT_L(0); PG8_MMA(0, 1, At, B1); PG8_BAR;
            PG8_LDA(At, 1, 1); PG8_STAGE(PG8_SA(1, 0), a3, voffA);
            PG8_BAR; PG8_WAIT_L(0); PG8_MMA(1, 0, At, B0); PG8_BAR; PG8_SCHED;
            PG8_STAGE(PG8_SB(1, 1), b3 + hstep, voffB);
            PG8_WAIT_V(6); PG8_BAR; PG8_MMA(1, 1, At, B1); PG8_BAR;
            }
        }
        if constexpr (ALIGN_EPI) { if (wr == 0) PG8_BAR; }
        if constexpr (!Epi::AFTER_DRAIN) { E(acc, cur, wr, wc, fr, fq); S.done(cur); }
        if (!has_next) break;
#pragma unroll
        for (int a = 0; a < 2; ++a)
#pragma unroll
            for (int b = 0; b < 2; ++b)
#pragma unroll
                for (int m = 0; m < 4; ++m)
#pragma unroll
                    for (int n = 0; n < 2; ++n) acc[a][b][m][n] = (f32x4){0.f, 0.f, 0.f, 0.f};
        cur = nxt; cA = nA; cB = nB; ++ui;
        if constexpr (ALIGN_EPI) { if (wr == 1) PG8_BAR; }
    }
    PG8_WAIT_V(0);
    if constexpr (!ALIGN_EPI) { if (wr == 0) PG8_BAR; }
    PG8_BAR;
    if constexpr (Epi::AFTER_DRAIN) { E.fused(acc, cur, wr, wc, fr, fq, lds, wid, lane); S.done(cur); }
#undef PG8_SA
#undef PG8_SB
#undef PG8_STAGE
#undef PG8_LDA
#undef PG8_LDB
#undef PG8_MMA
#undef PG8_WAIT_V
#undef PG8_WAIT_L
#undef PG8_BAR
#undef PG8_SCHED
}
}
constexpr int NWAVES = 8;
constexpr int DM = 1024, NB = 16, SEQ = 4096, MP = NB * SEQ  , SB = 128, ST = 8, MS = SB * ST  , MTOT = MP + MS  ;
constexpr int NIN = 3840;
constexpr int HA = 8, HD = 64, DA = 512, HB = 4, DKB = 64, DVB = 128, DBB = 512, RANK = 16, WIN = 2048, PAST = 8192;
constexpr float EPS = 1e-6f;
constexpr float LOG2E = 1.4426950408889634f;
constexpr float QSCALE = 0.125f * LOG2E;
constexpr size_t OUT_YP = 0, OUT_YS = OUT_YP + (size_t)MP * DM, OUT_KWIN = OUT_YS + (size_t)MS * DM, OUT_VWIN = OUT_KWIN + (size_t)NB * WIN * DA,
                 OUT_SP = OUT_VWIN + (size_t)NB * WIN * DA, OUT_KNEW = OUT_SP + (size_t)NB * HB * DKB * DVB, OUT_VNEW = OUT_KNEW + (size_t)MS * DA,
                 OUT_SS = OUT_VNEW + (size_t)MS * DA, OUT_END = OUT_SS + (size_t)SB * HB * DKB * DVB;
constexpr size_t MiB = 1u << 20;
constexpr size_t WS_CTL = 0, CTL_ZERO_BYTES = 1 * MiB;
constexpr size_t WS_WIN = 2 * MiB;
constexpr size_t WS_WOUT = 10 * MiB;
constexpr size_t WS_ROPE = 12 * MiB;
constexpr size_t WS_RSTD = 14 * MiB;
constexpr size_t WS_SCAL = 15 * MiB;
constexpr size_t WS_XB = 16 * MiB;
constexpr size_t WS_Q = 160 * MiB, WS_K = 228 * MiB, WS_V = 296 * MiB;
constexpr size_t WS_QB = 364 * MiB, WS_KB = 398 * MiB;
constexpr size_t WS_VB = 432 * MiB;
constexpr size_t WS_LOGA = 500 * MiB;
constexpr size_t WS_GA = 568 * MiB, WS_GB = 636 * MiB;
constexpr size_t WS_OPART = 704 * MiB;
constexpr size_t WS_LPART = 900 * MiB;
constexpr size_t WS_MIX = 908 * MiB;
constexpr size_t WS_END = 1040 * MiB;
constexpr size_t OPART_STRIDE = (size_t)MP * DA;
constexpr size_t LPART_STRIDE = (size_t)MP * HA;
constexpr int CW_TMO = 0, CW_CODE = 1;
constexpr int CW_TICKET = 64;
constexpr int CW_TICKET2 = 128;
constexpr int CW_P0A = 192;
constexpr int CW_BAR = 4096;
constexpr int RING_OFF = 0, RING_BYTES = 131072;
constexpr int LDSCTL_OFF = RING_BYTES, MISC_OFF = LDSCTL_OFF + 320;
constexpr int OSTAGE_OFF = LDSCTL_OFF + 512, LDS_BYTES = OSTAGE_OFF + 16384;
#define GAS __attribute__((address_space(1)))
#define LAS __attribute__((address_space(3)))
typedef unsigned short bf16;
typedef unsigned v4u __attribute__((ext_vector_type(4)));
typedef unsigned v2u __attribute__((ext_vector_type(2)));
typedef float f32x4 __attribute__((ext_vector_type(4)));
typedef float f32x2 __attribute__((ext_vector_type(2)));
typedef float f32x16 __attribute__((ext_vector_type(16)));
typedef short bf16x8 __attribute__((ext_vector_type(8)));
typedef short s16x4 __attribute__((ext_vector_type(4)));
typedef GAS unsigned gu32;
#define RLX_AGENT __ATOMIC_RELAXED, __HIP_MEMORY_SCOPE_AGENT
#define LDS_WAIT() asm volatile("s_waitcnt lgkmcnt(0)" ::: "memory")
#define NTLD(p) __builtin_nontemporal_load(p)
#define VM_WAIT() asm volatile("s_waitcnt vmcnt(0)" ::: "memory")
#define LBAR() do { asm volatile("s_waitcnt lgkmcnt(0)" ::: "memory"); __builtin_amdgcn_s_barrier(); asm volatile("" ::: "memory"); } while (0)
__device__ __forceinline__ unsigned f2bf(float f) { unsigned u = __builtin_bit_cast(unsigned, f); return (u + 0x7fffu + ((u >> 16) & 1u)) >> 16; }
__device__ __forceinline__ unsigned pk2(float lo, float hi) { typedef float f2 __attribute__((ext_vector_type(2))); typedef __bf16 b2 __attribute__((ext_vector_type(2))); f2 v = {lo, hi}; b2 b = __builtin_convertvector(v, b2); return __builtin_bit_cast(unsigned, b); }
__device__ __forceinline__ float bflo(unsigned u) { return __builtin_bit_cast(float, u << 16); }
__device__ __forceinline__ float bfhi(unsigned u) { return __builtin_bit_cast(float, u & 0xffff0000u); }
__device__ __forceinline__ v4u pack8(const f32x4 a, const f32x4 b) { v4u w; w.x = pk2(a[0], a[1]); w.y = pk2(a[2], a[3]); w.z = pk2(b[0], b[1]); w.w = pk2(b[2], b[3]); return w; }
__device__ __forceinline__ float wave_sum(float v) {
#pragma unroll
    for (int o = 1; o < 64; o <<= 1) v += __shfl_xor(v, o);
    return v;
}
__device__ __forceinline__ float wave_max(float v) {
#pragma unroll
    for (int o = 1; o < 64; o <<= 1) v = fmaxf(v, __shfl_xor(v, o));
    return v;
}
__device__ __forceinline__ float fast_exp2(float x) { return __builtin_amdgcn_exp2f(x); }
__device__ __forceinline__ float fast_exp(float x) { return __builtin_amdgcn_exp2f(x * LOG2E); }
__device__ __forceinline__ float silu_f(float x) { return x * __builtin_amdgcn_rcpf(1.0f + fast_exp(-x)); }
struct TileT {
    LAS unsigned char* T; int w0, w1, wa0, wa1, ro, rr, p;
    __device__ __forceinline__ void init(LAS unsigned char* stg, int wid, int fr, int fq) {
        T = stg + wid * 2048; const int lane = fr + 16 * fq; rr = lane >> 3; p = lane & 7; const int k = fr & 7;
        w0 = fr * 128 + ((fq ^ k) << 4); w1 = fr * 128 + (((4 + fq) ^ k) << 4);
        wa0 = fr * 128 + (((2 * fq) ^ k) << 4); wa1 = fr * 128 + (((2 * fq + 1) ^ k) << 4);
        ro = rr * 128 + ((p ^ rr) << 4);
    }
    __device__ __forceinline__ void bf(const v4u x0, const v4u x1, v4u& a, v4u& b) const {
        *(LAS v4u*)(T + w0) = x0; *(LAS v4u*)(T + w1) = x1; a = *(const LAS v4u*)(T + ro); b = *(const LAS v4u*)(T + ro + 1024); }
    __device__ __forceinline__ void f4(const f32x4 x0, const f32x4 x1, f32x4& a, f32x4& b) const {
        *(LAS f32x4*)(T + wa0) = x0; *(LAS f32x4*)(T + wa1) = x1; a = *(const LAS f32x4*)(T + ro); b = *(const LAS f32x4*)(T + ro + 1024); }
};
struct EpiIn {
    static constexpr bool PERM = true, AFTER_DRAIN = false;
    const float* rstd; const float* rope; const float* nwb  ; const float* bgate;
    unsigned char* ws; float* out; LAS unsigned char* stg;
    __device__ __forceinline__ void operator()(const f32x4 (&acc)[2][2][4][2], const pg8::Unit& u, int wr, int wc, int fr, int fq) const {
        asm volatile("" : "+v"(fr), "+v"(fq));
        const int pn = u.pn, pm = u.pm;
        const bool sample = pm >= (MP / 256);
        TileT tt; tt.init(stg, wr * 4 + wc, fr, fq);
        float rs8[2][4];
#pragma unroll
        for (int ai = 0; ai < 2; ++ai)
#pragma unroll
            for (int m = 0; m < 4; ++m) rs8[ai][m] = rstd[256 * pm + 128 * ai + 64 * wr + 16 * m + fr];
        if (pn < 4) {
            const int head = 4 * (pn & 1) + wc; const bool isq = pn < 2;
            const float* nw = nwb + (isq ? 0 : 64);
            f32x4 w[2][2];
#pragma unroll
            for (int bj = 0; bj < 2; ++bj)
#pragma unroll
                for (int n = 0; n < 2; ++n) w[bj][n] = *(const f32x4*)(nw + 32 * bj + 8 * fq + 4 * n);
            bf16* dst = (bf16*)(ws + (isq ? WS_Q : WS_K));
            const bool wout = !isq && (sample || (pm & 15) >= 8);
            const int rbase = 64 * wr + fr;
            f32x4 tn[4];
            { const int ri0 = sample ? (SEQ + (rbase & 7)) : (256 * (pm & 15) + rbase); const f32x4* tp0 = (const f32x4*)(rope + (size_t)ri0 * 64 + 16 * fq);
#pragma unroll
              for (int q = 0; q < 4; ++q) tn[q] = tp0[q]; }
#pragma unroll
            for (int ai = 0; ai < 2; ++ai)
#pragma unroll
                for (int m = 0; m < 4; ++m) {
                    const int rit = 128 * ai + 16 * m + rbase;
                    f32x4 tc[4];
#pragma unroll
                    for (int q = 0; q < 4; ++q) tc[q] = tn[q];
                    if (ai * 4 + m < 7) {
                        const int ritn = rit + (m == 3 ? 80 : 16); const int rin = sample ? (SEQ + (ritn & 7)) : (256 * (pm & 15) + ritn);
                        const f32x4* tpn = (const f32x4*)(rope + (size_t)rin * 64 + 16 * fq);
#pragma unroll
                        for (int q = 0; q < 4; ++q) tn[q] = tpn[q];
                    }
                    const float rs = rs8[ai][m];
                    f32x4 x[2][2]; float ss = 0.f;
#pragma unroll
                    for (int bj = 0; bj < 2; ++bj)
#pragma unroll
                        for (int n = 0; n < 2; ++n) { x[bj][n] = acc[ai][bj][m][n] * rs; const f32x4 t = x[bj][n]; ss += (t[0] * t[0] + t[1] * t[1]) + (t[2] * t[2] + t[3] * t[3]); }
                    ss += __shfl_xor(ss, 16); ss += __shfl_xor(ss, 32);
                    const float rn = __builtin_amdgcn_rsqf(ss * (1.0f / 64.0f) + EPS);
                    f32x4 o1[2], o2[2];
#pragma unroll
                    for (int n = 0; n < 2; ++n) {
                        const f32x4 ta = tc[2 * n], tb = tc[2 * n + 1];
                        const f32x4 y1 = x[0][n] * rn * w[0][n], y2 = x[1][n] * rn * w[1][n];
                        const f32x4 c = {ta[0], ta[2], tb[0], tb[2]}, s = {ta[1], ta[3], tb[1], tb[3]};
                        o1[n] = y1 * c - y2 * s; o2[n] = y2 * c + y1 * s;
                    }
                    const int rowa = 256 * pm + 128 * ai + 64 * wr + 16 * m + tt.rr;
                    { v4u a, b; if (isq) tt.bf(pack8(o1[0] * QSCALE, o1[1] * QSCALE), pack8(o2[0] * QSCALE, o2[1] * QSCALE), a, b); else tt.bf(pack8(o1[0], o1[1]), pack8(o2[0], o2[1]), a, b);
                      bf16* d = dst + (size_t)rowa * DA + head * 64 + 8 * tt.p; *(v4u*)d = a; *(v4u*)(d + 8 * DA) = b; }
                    if (wout) {
                        const int rl = 128 * ai + 64 * wr + 16 * m + tt.rr;
                        float* op = sample ? out + OUT_KNEW + (size_t)(rowa - MP) * DA : out + OUT_KWIN + ((size_t)(pm >> 4) * WIN + (256 * (pm & 15) + rl - (SEQ - WIN))) * DA;
                        op += head * 64 + 4 * tt.p;
                        f32x4 a, b; tt.f4(o1[0], o1[1], a, b); *(f32x4*)op = a; *(f32x4*)(op + 8 * DA) = b;
                        tt.f4(o2[0], o2[1], a, b); *(f32x4*)(op + 32) = a; *(f32x4*)(op + 32 + 8 * DA) = b;
                    }
                }
        } else if (pn < 6) {
            const int head = 4 * (pn & 1) + wc;
            const bool wout = sample || (pm & 15) >= 8;
#pragma unroll
            for (int ai = 0; ai < 2; ++ai)
#pragma unroll
                for (int m = 0; m < 4; ++m) {
                    const int rl = 128 * ai + 64 * wr + 16 * m + tt.rr, rowa = 256 * pm + rl;
                    const float rs = rs8[ai][m];
                    const f32x4 a0 = acc[ai][0][m][0] * rs, a1 = acc[ai][0][m][1] * rs, b0 = acc[ai][1][m][0] * rs, b1 = acc[ai][1][m][1] * rs;
                    { v4u a, b; tt.bf(pack8(a0, a1), pack8(b0, b1), a, b);
                      bf16* d = (bf16*)(ws + WS_V) + (size_t)rowa * DA + head * 64 + 8 * tt.p; *(v4u*)d = a; *(v4u*)(d + 8 * DA) = b; }
                    if (wout) {
                        float* op = sample ? out + OUT_VNEW + (size_t)(rowa - MP) * DA : out + OUT_VWIN + ((size_t)(pm >> 4) * WIN + (256 * (pm & 15) + rl - (SEQ - WIN))) * DA;
                        op += head * 64 + 4 * tt.p;
                        f32x4 a, b; tt.f4(a0, a1, a, b); *(f32x4*)op = a; *(f32x4*)(op + 8 * DA) = b;
                        tt.f4(b0, b1, a, b); *(f32x4*)(op + 32) = a; *(f32x4*)(op + 32 + 8 * DA) = b;
                    }
                }
        } else if (pn < 8) {
            bf16* dst = (bf16*)(ws + (pn == 6 ? WS_QB : WS_KB)); const float sc = pn == 6 ? 0.125f : 1.0f;
#pragma unroll
            for (int ai = 0; ai < 2; ++ai)
#pragma unroll
                for (int m = 0; m < 4; ++m) {
                    const int rowa = 256 * pm + 128 * ai + 64 * wr + 16 * m + tt.rr;
                    const float rs = rs8[ai][m] * sc;
                    v4u a, b; tt.bf(pack8(acc[ai][0][m][0] * rs, acc[ai][0][m][1] * rs), pack8(acc[ai][1][m][0] * rs, acc[ai][1][m][1] * rs), a, b);
                    bf16* d = dst + (size_t)rowa * 256 + wc * 64 + 8 * tt.p; *(v4u*)d = a; *(v4u*)(d + 8 * 256) = b;
                }
        } else if (pn < 14) {
            bf16* dst = (bf16*)(ws + (pn < 10 ? WS_VB : (pn < 12 ? WS_GA : WS_GB))); const bool act = pn >= 10;
            const int cb = 256 * (pn & 1) + 64 * wc + 8 * tt.p;
#pragma unroll
            for (int ai = 0; ai < 2; ++ai)
#pragma unroll
                for (int m = 0; m < 4; ++m) {
                    const int rowa = 256 * pm + 128 * ai + 64 * wr + 16 * m + tt.rr;
                    const float rs = rs8[ai][m];
                    v4u pk[2];
#pragma unroll
                    for (int bj = 0; bj < 2; ++bj) {
                        f32x4 a = acc[ai][bj][m][0] * rs, b = acc[ai][bj][m][1] * rs;
                        if (act) {
#pragma unroll
                            for (int j = 0; j < 4; ++j) { a[j] = silu_f(a[j]); b[j] = silu_f(b[j]); }
                        }
                        pk[bj] = pack8(a, b);
                    }
                    v4u a, b; tt.bf(pk[0], pk[1], a, b);
                    bf16* d = dst + (size_t)rowa * 512 + cb; *(v4u*)d = a; *(v4u*)(d + 8 * 512) = b;
                }
        } else {
            f32x4 bg[2][2];
#pragma unroll
            for (int bj = 0; bj < 2; ++bj)
#pragma unroll
                for (int n = 0; n < 2; ++n) bg[bj][n] = *(const f32x4*)(bgate + 64 * wc + 32 * bj + 8 * fq + 4 * n);
#pragma unroll
            for (int ai = 0; ai < 2; ++ai)
#pragma unroll
                for (int m = 0; m < 4; ++m) {
                    const int rowa = 256 * pm + 128 * ai + 64 * wr + 16 * m + tt.rr;
                    const float rs = rs8[ai][m];
                    v4u pk[2];
#pragma unroll
                    for (int bj = 0; bj < 2; ++bj) {
                        f32x4 r2[2];
#pragma unroll
                        for (int n = 0; n < 2; ++n) {
                            const f32x4 z = acc[ai][bj][m][n] * rs + bg[bj][n];
#pragma unroll
                            for (int j = 0; j < 4; ++j) { const float az = fabsf(z[j]); r2[n][j] = (fminf(z[j], 0.f) - __logf(1.0f + fast_exp(-az))) * (1.0f / 16.0f); }
                        }
                        pk[bj] = pack8(r2[0], r2[1]);
                    }
                    v4u a, b; tt.bf(pk[0], pk[1], a, b);
                    bf16* d = (bf16*)(ws + WS_LOGA) + (size_t)rowa * 256 + 64 * wc + 8 * tt.p; *(v4u*)d = a; *(v4u*)(d + 8 * 256) = b;
                }
        }
    }
};
struct EpiOut {
    static constexpr bool PERM = false, AFTER_DRAIN = false;
    const bf16* xbf; float* out; LAS unsigned char* stg;
    __device__ __forceinline__ void operator()(const f32x4 (&acc)[2][2][4][2], const pg8::Unit& u, int wr, int wc, int fr, int fq) const {
        asm volatile("" : "+v"(fr), "+v"(fq));
        const int pm = u.pm; const bool sample = pm >= (MP / 256);
        const bf16* xb = xbf + (size_t)pm * 256 * DM;
        float* ob = sample ? out + OUT_YS + (size_t)(pm - MP / 256) * 256 * DM : out + OUT_YP + (size_t)pm * 256 * DM;
        LAS unsigned char* T = stg + (wr * 4 + wc) * 2048;
        const int lane = fr + 16 * fq, rr = lane >> 3, p = lane & 7;
        const int woff0 = fr * 128 + ((fq ^ (fr & 7)) << 4), woff1 = fr * 128 + (((4 + fq) ^ (fr & 7)) << 4);
        const int roff = rr * 128 + ((p ^ rr) << 4);
        const int cb = 256 * u.pn + 32 * wc + 4 * p;
#pragma unroll
        for (int ai = 0; ai < 2; ++ai) {
            v4u xv[4][2][2];
#pragma unroll
            for (int m = 0; m < 4; ++m) {
                const size_t ro = (size_t)(128 * ai + 64 * wr + 16 * m + rr) * DM + (cb & ~7);
#pragma unroll
                for (int bj = 0; bj < 2; ++bj) { xv[m][bj][0] = NTLD((const v4u*)(xb + ro + 128 * bj)); xv[m][bj][1] = NTLD((const v4u*)(xb + ro + 8 * DM + 128 * bj)); }
            }
#pragma unroll
            for (int m = 0; m < 4; ++m) {
                const size_t ro = (size_t)(128 * ai + 64 * wr + 16 * m + rr) * DM + cb;
#pragma unroll
                for (int bj = 0; bj < 2; ++bj) {
                    *(LAS f32x4*)(T + woff0) = acc[ai][bj][m][0]; *(LAS f32x4*)(T + woff1) = acc[ai][bj][m][1];
                    const f32x4 a0 = *(const LAS f32x4*)(T + roff), a1 = *(const LAS f32x4*)(T + roff + 1024);
                    const v4u t0 = xv[m][bj][0], t1 = xv[m][bj][1];
                    const unsigned u0 = (p & 1) ? t0.z : t0.x, u1 = (p & 1) ? t0.w : t0.y, u2 = (p & 1) ? t1.z : t1.x, u3 = (p & 1) ? t1.w : t1.y;
                    *(f32x4*)(ob + ro + 128 * bj) = (f32x4){bflo(u0), bfhi(u0), bflo(u1), bfhi(u1)} + a0; *(f32x4*)(ob + ro + 8 * DM + 128 * bj) = (f32x4){bflo(u2), bfhi(u2), bflo(u3), bfhi(u3)} + a1;
                }
            }
        }
    }
};
#define XB_TMO      128
#define XB_XCNT(j)  (256  + 64 * (j))
#define XB_XSUB(j)  (1280 + 64 * (j))
#define XB_XGEN(j)  (2304 + 64 * (j))
#define XB_TOP      3328
#define XB_TOPGEN   3392
#define XCD_BAR_WORDS 3456
#define XB_SPIN_CAP (1u << 18)

__device__ __forceinline__ unsigned xb_ld(unsigned* p)              { return __hip_atomic_load(p, __ATOMIC_RELAXED, __HIP_MEMORY_SCOPE_AGENT); }
__device__ __forceinline__ unsigned xb_add(unsigned* p, unsigned v) { return __hip_atomic_fetch_add(p, v, __ATOMIC_RELAXED, __HIP_MEMORY_SCOPE_AGENT); }
__device__ __forceinline__ unsigned xb_xcc_id() { return (unsigned)__builtin_amdgcn_s_getreg((3 << 11) | 20) & 0xFu; }
#define XB_SPIN(cond, bar) do { unsigned _sp = 0; while (cond) { __builtin_amdgcn_s_sleep(1); \
    if ((++_sp & 255u) == 0u) { if (xb_ld(&(bar)[XB_TMO])) break; if (_sp > XB_SPIN_CAP) { atomicAdd(&(bar)[XB_TMO], 1u); break; } } } } while (0)

struct XcdBarrier {
    unsigned* bar; unsigned x;
    volatile LAS unsigned* st;
};

__device__ __forceinline__ XcdBarrier xcd_barrier_post(unsigned* bar, volatile LAS unsigned* st) {
    XcdBarrier b; b.bar = bar; b.x = xb_xcc_id(); b.st = st;
    if (threadIdx.x == 0) (void)xb_add(&bar[XB_XCNT(b.x)], 1u);
    return b;
}
__device__ __forceinline__ void xcd_barrier_complete(unsigned* bar, unsigned x, unsigned& nloc, unsigned& nx) {
    const unsigned G = gridDim.x * gridDim.y * gridDim.z;
    unsigned sum, cnt, mine, sp = 0u;
    for (;;) {
        sum = 0u; cnt = 0u; mine = 0u;
#pragma unroll
        for (unsigned j = 0; j < 16; ++j) { const unsigned c = xb_ld(&bar[XB_XCNT(j)]); sum += c; cnt += (c > 0u) ? 1u : 0u; mine = (j == x) ? c : mine; }
        if (sum == G) break;
        __builtin_amdgcn_s_sleep(1);
        if ((++sp & 255u) == 0u) { if (xb_ld(&bar[XB_TMO])) break; if (sp > XB_SPIN_CAP) { atomicAdd(&bar[XB_TMO], 1u); break; } }
    }
    nloc = mine > 0u ? mine : 1u; nx = cnt > 0u ? cnt : 1u;
}

__device__ __forceinline__ void xcd_barrier(const XcdBarrier& b) {
    asm volatile("s_waitcnt vmcnt(0)" ::: "memory");
    __syncthreads();
    if (threadIdx.x == 0) {
        unsigned* bar = b.bar;
        __builtin_amdgcn_s_waitcnt(0);
        unsigned nloc = b.st[0], nx = b.st[1];
        if (nloc == 0u) { xcd_barrier_complete(bar, b.x, nloc, nx); b.st[0] = nloc; b.st[1] = nx; }
        const unsigned old = xb_add(&bar[XB_XSUB(b.x)], 1u);
        const unsigned gen = old / nloc;
        if (old + 1u == (gen + 1u) * nloc) {
            __builtin_amdgcn_fence(__ATOMIC_RELEASE, "agent");
            asm volatile("s_waitcnt vmcnt(0)" ::: "memory");
            const unsigned og = xb_add(&bar[XB_TOP], 1u);
            const unsigned tg = og / nx;
            if (og + 1u == (tg + 1u) * nx) xb_add(&bar[XB_TOPGEN], 1u);
            else XB_SPIN(xb_ld(&bar[XB_TOPGEN]) == tg, bar);
            __builtin_amdgcn_fence(__ATOMIC_ACQUIRE, "agent");
            xb_add(&bar[XB_XGEN(b.x)], 1u);
            asm volatile("s_waitcnt vmcnt(0)" ::: "memory");
        } else {
            XB_SPIN(xb_ld(&bar[XB_XGEN(b.x)]) == gen, bar);
            __builtin_amdgcn_fence(__ATOMIC_ACQUIRE, "agent");
            asm volatile("s_waitcnt vmcnt(0)" ::: "memory");
        }
    }
    __syncthreads();
}
struct Args { const float* in[13]; float* out; unsigned char* ws; int ph_lo, ph_hi, item_mask, pad; };
struct Frame {
    LAS unsigned char* lds; volatile LAS unsigned* MISC; gu32* ctl;
    int tid, lane, wave, G, item_mask;
    float* out; unsigned char* ws;
};
__device__ __forceinline__ const Args* args_ptr() {
#if defined(__HIP_DEVICE_COMPILE__)
    const void* p = (const void*)__builtin_amdgcn_kernarg_segment_ptr(); asm volatile("" : "+s"(p)); return (const Args*)p;
#else
    return nullptr;
#endif
}
#define INP(k) (args_ptr()->in[k])
enum { I_XP = 0, I_XS, I_CK, I_CV, I_SG, I_NORMW, I_WIN, I_WGU, I_BGATE, I_QNW, I_KNW, I_GNW, I_WOUT };
#define WSP(T, off) ((T*)(F.ws + (off)))

__device__ __forceinline__ void p0_transpose_item(const float* W, int ldw, int srccol0, const float* kscale, bf16* WT, int K, int dstrow0, LAS float* scr, int k0, int lane) {
    float wv[32], sv[32];
#pragma unroll
    for (int i = 0; i < 32; ++i) { const int kk = 2 * i + (lane >> 5); wv[i] = W[(size_t)(k0 + kk) * ldw + srccol0 + (lane & 31)]; }
#pragma unroll
    for (int i = 0; i < 32; ++i) { const int kk = 2 * i + (lane >> 5); sv[i] = kscale ? kscale[k0 + kk] : 1.0f; }
#pragma unroll
    for (int i = 0; i < 32; ++i) { const int kk = 2 * i + (lane >> 5); scr[kk * 33 + (lane & 31)] = wv[i] * sv[i]; }
    LDS_WAIT(); asm volatile("" ::: "memory");
    const int c = lane & 7;
#pragma unroll
    for (int j = 0; j < 4; ++j) { const int n = (lane >> 3) + 8 * j; const LAS float* s = scr + (8 * c) * 33 + n;
        v4u o; o.x = pk2(s[0 * 33], s[1 * 33]); o.y = pk2(s[2 * 33], s[3 * 33]); o.z = pk2(s[4 * 33], s[5 * 33]); o.w = pk2(s[6 * 33], s[7 * 33]);
        *(v4u*)(WT + (size_t)(dstrow0 + n) * K + k0 + 8 * c) = o; }
    LDS_WAIT(); asm volatile("" ::: "memory");
}
__device__ __forceinline__ int in_src_col(int n0) {
    const int pn = n0 >> 8, within = n0 & 255, bj = within >> 7, wc = (within & 127) >> 5;
    if (pn < 6) return 512 * (pn >> 1) + 64 * (4 * (pn & 1) + wc) + 32 * bj;
    if (pn == 6) return 1536 + 64 * wc + 32 * bj;
    if (pn == 7) return 1792 + 64 * wc + 32 * bj;
    if (pn < 10) return 2048 + 256 * (pn - 8) + 64 * wc + 32 * bj;
    if (pn < 12) return 2576 + 256 * (pn - 10) + 64 * wc + 32 * bj;
    return 3088 + 256 * (pn - 12) + 64 * wc + 32 * bj;
}
__device__ __forceinline__ void p0_convert_row(Frame& F, const float* xp_, const float* xs_, int m) {
    const float* xrow = m < MP ? xp_ + (size_t)m * DM : xs_ + (size_t)(m - MP) * DM;
    const f32x4* xr = (const f32x4*)xrow + F.lane;
    f32x4 v[4]; float s = 0.f;
#pragma unroll
    for (int j = 0; j < 4; ++j) { v[j] = NTLD(xr + 64 * j); s += (v[j][0] * v[j][0] + v[j][1] * v[j][1]) + (v[j][2] * v[j][2] + v[j][3] * v[j][3]); }
    s = wave_sum(s);
    if (F.lane == 0) WSP(float, WS_RSTD)[m] = 1.0f / sqrtf(s * (1.0f / DM) + EPS);
    v2u* o8 = (v2u*)(WSP(bf16, WS_XB) + (size_t)m * DM) + F.lane;
#pragma unroll
    for (int j = 0; j < 4; ++j) { v2u o; o.x = pk2(v[j][0], v[j][1]); o.y = pk2(v[j][2], v[j][3]); o8[64 * j] = o; }
}
__device__ __forceinline__ void p0_convert_row2(Frame& F, const float* xp_, int m0, int m1) {
    const f32x4* xa = (const f32x4*)(xp_ + (size_t)m0 * DM) + F.lane; const f32x4* xb = (const f32x4*)(xp_ + (size_t)m1 * DM) + F.lane;
    f32x4 va[4], vb[4]; float sa = 0.f, sb = 0.f;
#pragma unroll
    for (int j = 0; j < 4; ++j) { va[j] = NTLD(xa + 64 * j); vb[j] = NTLD(xb + 64 * j); }
#pragma unroll
    for (int j = 0; j < 4; ++j) { sa += (va[j][0] * va[j][0] + va[j][1] * va[j][1]) + (va[j][2] * va[j][2] + va[j][3] * va[j][3]); sb += (vb[j][0] * vb[j][0] + vb[j][1] * vb[j][1]) + (vb[j][2] * vb[j][2] + vb[j][3] * vb[j][3]); }
    sa = wave_sum(sa); sb = wave_sum(sb);
    if (F.lane == 0) { WSP(float, WS_RSTD)[m0] = 1.0f / sqrtf(sa * (1.0f / DM) + EPS); WSP(float, WS_RSTD)[m1] = 1.0f / sqrtf(sb * (1.0f / DM) + EPS); }
    v2u* oa = (v2u*)(WSP(bf16, WS_XB) + (size_t)m0 * DM) + F.lane; v2u* ob = (v2u*)(WSP(bf16, WS_XB) + (size_t)m1 * DM) + F.lane;
#pragma unroll
    for (int j = 0; j < 4; ++j) { v2u o; o.x = pk2(va[j][0], va[j][1]); o.y = pk2(va[j][2], va[j][3]); oa[64 * j] = o; v2u p; p.x = pk2(vb[j][0], vb[j][1]); p.y = pk2(vb[j][2], vb[j][3]); ob[64 * j] = p; }
}
__device__ __forceinline__ void p0_prologue(Frame& F) {
    const Args* A_ = args_ptr();
    const float *xp_ = A_->in[I_XP], *xs_ = A_->in[I_XS], *normw_ = A_->in[I_NORMW], *win_ = A_->in[I_WIN], *wgu_ = A_->in[I_WGU], *qnw_ = A_->in[I_QNW], *knw_ = A_->in[I_KNW], *wout_ = A_->in[I_WOUT];
    LAS float* scr = (LAS float*)(F.lds + RING_OFF + F.wave * 16384);
    bf16* WinT = WSP(bf16, WS_WIN); bf16* WoutT = WSP(bf16, WS_WOUT);
    const int bx = (int)blockIdx.x;
    constexpr int G_TR = 144, G_GW = 32, G_RO = 16;
    if (bx < G_TR) {
        constexpr int I_IN = 112 * 16, I_OUT = 32 * 16;
        for (int it = bx * NWAVES + F.wave; it < I_IN + I_OUT; it += G_TR * NWAVES) {
            if (it < I_IN) { const int ng = it >> 4, kb = it & 15; p0_transpose_item(win_, 3600, in_src_col(32 * ng), normw_, WinT, DM, 32 * ng, scr, 64 * kb, F.lane); }
            else { const int r = it - I_IN, ng = r >> 4, kb = r & 15; p0_transpose_item(wout_, DM, 32 * ng, nullptr, WoutT, DM, 32 * ng, scr, 64 * kb, F.lane); }
        }
    } else if (bx < G_TR + G_GW) {
        for (int it = (bx - G_TR) * (NWAVES * 64) + F.tid; it < 256 * 128; it += G_GW * NWAVES * 64) {
            const int c = it & 255, k8 = it >> 8; float r[8];
            const int lc = 64 * ((c >> 5) & 3) + 32 * (c >> 7) + (c & 31);
#pragma unroll
            for (int kk = 0; kk < 8; ++kk) { const int k = 8 * k8 + kk; const float* wr_ = win_ + (size_t)k * 3600 + 2560; float s = 0.f;
#pragma unroll
                for (int q = 0; q < RANK; ++q) s += wr_[q] * wgu_[q * 256 + lc];
                r[kk] = s * normw_[k]; }
            v4u o; o.x = pk2(r[0], r[1]); o.y = pk2(r[2], r[3]); o.z = pk2(r[4], r[5]); o.w = pk2(r[6], r[7]);
            *(v4u*)(WinT + (size_t)(3584 + c) * DM + 8 * k8) = o;
        }
    } else if (bx < G_TR + G_GW + G_RO) {
        float* rope = WSP(float, WS_ROPE);
        for (int it = (bx - G_TR - G_GW) * (NWAVES * 64) + F.tid; it < (SEQ + ST) * 32; it += G_RO * NWAVES * 64) {
            const int ri = it >> 5, d = it & 31; const float pos = (float)(ri < SEQ ? ri : PAST + (ri - SEQ));
            const float invf = exp2f(-(float)d * (13.287712379549449f / 32.0f));
            float s, c; sincosf(pos * invf, &s, &c);
            rope[2 * it] = c; rope[2 * it + 1] = s;
        }
        if (bx == G_TR + G_GW && F.wave == 0) {
            const float mq = wave_max(fabsf(qnw_[F.lane])), mk = wave_max(fabsf(knw_[F.lane]));
            if (F.lane == 0) WSP(float, WS_SCAL)[0] = 8.0f * LOG2E * mq * mk;
            WSP(float, WS_SCAL)[64 + F.lane] = qnw_[F.lane]; WSP(float, WS_SCAL)[128 + F.lane] = knw_[F.lane];
        }
    } else {
        const int ng = F.G - (G_TR + G_GW + G_RO);
        for (int m = MP + (bx - (G_TR + G_GW + G_RO)) * NWAVES + F.wave; m < MTOT; m += ng * NWAVES) p0_convert_row(F, xp_, xs_, m);
    }
}
__device__ __forceinline__ void p0b_convert(Frame& F) {
    const Args* A_ = args_ptr(); const float *xp_ = A_->in[I_XP], *xs_ = A_->in[I_XS];
    if (F.tid == 0) F.MISC[5] = __hip_atomic_fetch_add(F.ctl + CW_TICKET2, 1u, RLX_AGENT);
    LBAR(); int t = __builtin_amdgcn_readfirstlane((int)F.MISC[5]); LBAR();
    while (t < MP / 64) {
        unsigned nt = 0u;
        if (F.tid == 0) nt = __hip_atomic_fetch_add(F.ctl + CW_TICKET2, 1u, RLX_AGENT);
#pragma unroll 1
        for (int i = 0; i < 8; i += 2) p0_convert_row2(F, xp_, 64 * t + 8 * i + F.wave, 64 * t + 8 * (i + 1) + F.wave);
        if (F.tid == 0) F.MISC[5] = nt;
        LBAR(); t = __builtin_amdgcn_readfirstlane((int)F.MISC[5]); LBAR();
    }
}
typedef short v4i16_t __attribute__((ext_vector_type(4)));
__device__ __forceinline__ s16x4 tr16(const LAS unsigned char* p) { return __builtin_bit_cast(s16x4, __builtin_amdgcn_ds_read_tr16_b64_v4i16((LAS v4i16_t*)p)); }
__device__ __forceinline__ bf16x8 cat8(s16x4 lo, s16x4 hi) { return (bf16x8){lo[0], lo[1], lo[2], lo[3], hi[0], hi[1], hi[2], hi[3]}; }
__device__ __forceinline__ bf16x8 pk8(f32x4 a, f32x4 b) { return __builtin_bit_cast(bf16x8, pack8(a, b)); }
#define MFMA16(a, b, c) __builtin_amdgcn_mfma_f32_16x16x32_bf16((a), (b), (c), 0, 0, 0)
#define MFMA32(a, b, c) __builtin_amdgcn_mfma_f32_32x32x16_bf16((a), (b), (c), 0, 0, 0)

constexpr int G_QT = 0, G_RP = 144, G_KT = 9216, G_V = 18432, G_VP = 288, G_P = 36864, G_O = 46080, G_OP = 528, G_TOT = 79872, G_D = 83968;
__device__ __forceinline__ void gla_prompt_item(Frame& F, int b, int h) {
    int tid = F.tid; asm volatile("" : "+v"(tid));
    const int lane = tid & 63, w = __builtin_amdgcn_readfirstlane(tid >> 6), g = lane >> 4, i16 = lane & 15;
    LAS unsigned char* L = F.lds + RING_OFF;
    const bf16* QBp = WSP(bf16, WS_QB); const bf16* KBp = WSP(bf16, WS_KB); const bf16* VBp = WSP(bf16, WS_VB); const bf16* GBp = WSP(bf16, WS_GB);
    const bf16* LOGA = WSP(bf16, WS_LOGA); bf16* MIX = WSP(bf16, WS_MIX);
#ifdef PROBE_VARIANTS
    const int var = F.item_mask >> 8;
    if (var) MIX = WSP(bf16, (size_t)1100 * MiB);
#else
    constexpr int var = 0;
#endif
    const size_t tokb = (size_t)b * SEQ;
    const int kp = tid & 31, seg = tid >> 5;
    const int et = tid >> 3, evc = tid & 7;
    f32x4 gw4[4];
#pragma unroll
    for (int q = 0; q < 4; ++q) gw4[q] = *(const f32x4*)(INP(I_GNW) + 16 * evc + 4 * q);
    f32x4 sacc[4];
#pragma unroll
    for (int kb = 0; kb < 4; ++kb) sacc[kb] = (f32x4){0.f, 0.f, 0.f, 0.f};
    f32x2 lg[4]; unsigned qv[4], kv[4]; v4u vv[2]; v4u gg[2]; v4u outp[2] = {};
#define GLA_LOAD(n) do { const size_t t0_ = tokb + 64 * (size_t)(n); \
        _Pragma("unroll") for (int i = 0; i < 4; ++i) { const size_t tk = t0_ + 4 * seg + i; { const unsigned lr_ = *(const unsigned*)(LOGA + tk * 256 + h * 64 + 2 * kp); lg[i] = (f32x2){bflo(lr_), bfhi(lr_)}; } \
            qv[i] = *(const unsigned*)(QBp + tk * 256 + h * 64 + 2 * kp); kv[i] = *(const unsigned*)(KBp + tk * 256 + h * 64 + 2 * kp); } \
        _Pragma("unroll") for (int i = 0; i < 2; ++i) { const int p_ = tid + 512 * i, row_ = p_ >> 4, c_ = p_ & 15; vv[i] = *(const v4u*)(VBp + (t0_ + row_) * 512 + h * 128 + 8 * c_); } } while (0)
    GLA_LOAD(0);
    for (int n = 0; n < SEQ / 64; ++n) {
        const size_t t0 = tokb + 64 * (size_t)n;
        f32x2 cs[4]; cs[0] = lg[0];
#pragma unroll
        for (int i = 1; i < 4; ++i) cs[i] = cs[i - 1] + lg[i];
        *(LAS f32x2*)(L + G_TOT + (seg * 64 + 2 * kp) * 4) = cs[3];
#pragma unroll
        for (int i = 0; i < 2; ++i) { const int p_ = tid + 512 * i, row_ = p_ >> 4, c_ = p_ & 15; *(LAS v4u*)(L + G_V + row_ * G_VP + c_ * 16) = vv[i]; }
        LBAR();
        if (n > 0) {
#pragma unroll
            for (int i = 0; i < 2; ++i) *(v4u*)(MIX + (t0 - 64 + et) * DM + DA + h * 128 + 16 * evc + 8 * i) = outp[i];
        }
        f32x2 pre = {0.f, 0.f}, tot = {0.f, 0.f};
#pragma unroll
        for (int s = 0; s < 16; ++s) { const f32x2 v = *(const LAS f32x2*)(L + G_TOT + (s * 64 + 2 * kp) * 4); if (s < seg) pre += v; tot += v; }
#pragma unroll
        for (int i = 0; i < 4; ++i) {
            f32x2 bb = pre + cs[i]; bb.x = fmaxf(bb.x, -80.f); bb.y = fmaxf(bb.y, -80.f);
            const float ep0 = fast_exp(bb.x), ep1 = fast_exp(bb.y), em0 = fast_exp(-bb.x), em1 = fast_exp(-bb.y);
            const int t = 4 * seg + i;
            *(LAS unsigned*)(L + G_QT + t * G_RP + kp * 4) = pk2(bflo(qv[i]) * ep0, bfhi(qv[i]) * ep1);
            *(LAS unsigned*)(L + G_KT + t * G_RP + kp * 4) = pk2(bflo(kv[i]) * em0, bfhi(kv[i]) * em1);
        }
        if (seg == 0) { f32x2 dd; dd.x = fast_exp(fmaxf(tot.x, -80.f)); dd.y = fast_exp(fmaxf(tot.y, -80.f)); *(LAS f32x2*)(L + G_D + 2 * kp * 4) = dd; }
#pragma unroll
        for (int i = 0; i < 2; ++i) gg[i] = *(const v4u*)(GBp + (t0 + et) * 512 + h * 128 + 16 * evc + 8 * i);
        if (n + 1 < SEQ / 64 && var != 2) GLA_LOAD(n + 1);
        LBAR();
        if (var != 3) {
            const int tb = w >> 1;
#pragma unroll
            for (int q2 = 0; q2 < 2; ++q2) {
                const int sb = 2 * (w & 1) + q2;
                f32x4 c4 = {0.f, 0.f, 0.f, 0.f};
                if (sb <= tb) {
#pragma unroll
                    for (int sp = 0; sp < 2; ++sp) {
                        const bf16x8 a = *(const LAS bf16x8*)(L + G_KT + (16 * sb + i16) * G_RP + (32 * sp + 8 * g) * 2);
                        const bf16x8 bq = *(const LAS bf16x8*)(L + G_QT + (16 * tb + i16) * G_RP + (32 * sp + 8 * g) * 2);
                        c4 = MFMA16(a, bq, c4);
                    }
                }
                const int t = 16 * tb + i16, s0 = 16 * sb + 4 * g;
#pragma unroll
                for (int r = 0; r < 4; ++r) if (s0 + r > t) c4[r] = 0.f;
                v2u pk; pk.x = pk2(c4[0], c4[1]); pk.y = pk2(c4[2], c4[3]);
                *(LAS v2u*)(L + G_P + t * G_RP + s0 * 2) = pk;
            }
        }
        LBAR();
        if (var != 1) {
            bf16x8 vf[2];
#pragma unroll
            for (int sp = 0; sp < 2; ++sp) { const LAS unsigned char* vp = L + G_V + (32 * sp + 8 * g + (i16 >> 2)) * G_VP + (16 * w + 4 * (i16 & 3)) * 2; vf[sp] = cat8(tr16(vp), tr16(vp + 4 * G_VP)); }
            bf16x8 pa[4][2], qa[4][2];
#pragma unroll
            for (int tb = 0; tb < 4; ++tb)
#pragma unroll
                for (int sp = 0; sp < 2; ++sp) {
                    if (!(sp == 1 && tb < 2)) pa[tb][sp] = *(const LAS bf16x8*)(L + G_P + (16 * tb + i16) * G_RP + (32 * sp + 8 * g) * 2);
                    const v2u a0 = *(const LAS v2u*)(L + G_QT + (16 * tb + i16) * G_RP + (32 * sp + 4 * g) * 2);
                    const v2u a1 = *(const LAS v2u*)(L + G_QT + (16 * tb + i16) * G_RP + (32 * sp + 16 + 4 * g) * 2);
                    v4u aa; aa.x = a0.x; aa.y = a0.y; aa.z = a1.x; aa.w = a1.y; qa[tb][sp] = __builtin_bit_cast(bf16x8, aa);
                }
            bf16x8 bs[2];
#pragma unroll
            for (int sp = 0; sp < 2; ++sp) bs[sp] = pk8(sacc[2 * sp], sacc[2 * sp + 1]);
            __builtin_amdgcn_sched_barrier(0);
            f32x4 oacc[4];
#pragma unroll
            for (int tb = 0; tb < 4; ++tb) oacc[tb] = MFMA16(qa[tb][0], bs[0], ((f32x4){0.f, 0.f, 0.f, 0.f}));
#pragma unroll
            for (int tb = 0; tb < 4; ++tb) oacc[tb] = MFMA16(qa[tb][1], bs[1], oacc[tb]);
#pragma unroll
            for (int tb = 0; tb < 4; ++tb) oacc[tb] = MFMA16(pa[tb][0], vf[0], oacc[tb]);
#pragma unroll
            for (int tb = 2; tb < 4; ++tb) oacc[tb] = MFMA16(pa[tb][1], vf[1], oacc[tb]);
            __builtin_amdgcn_sched_barrier(0);
            bf16x8 ka[4][2]; f32x4 dv[4];
#pragma unroll
            for (int kb = 0; kb < 4; ++kb) {
#pragma unroll
                for (int sp = 0; sp < 2; ++sp) { const LAS unsigned char* kq = L + G_KT + (32 * sp + 8 * g + (i16 >> 2)) * G_RP + (16 * kb + 4 * (i16 & 3)) * 2; ka[kb][sp] = cat8(tr16(kq), tr16(kq + 4 * G_RP)); }
                dv[kb] = *(const LAS f32x4*)(L + G_D + (16 * kb + 4 * g) * 4);
            }
#pragma unroll
            for (int tb = 0; tb < 4; ++tb)
#pragma unroll
                for (int r = 0; r < 4; ++r) *(LAS float*)(L + G_O + (16 * tb + 4 * g + r) * G_OP + (16 * w + i16) * 4) = oacc[tb][r];
            __builtin_amdgcn_sched_barrier(0);
#pragma unroll
            for (int kb = 0; kb < 4; ++kb) sacc[kb] = MFMA16(ka[kb][0], vf[0], sacc[kb]);
#pragma unroll
            for (int kb = 0; kb < 4; ++kb) sacc[kb] = MFMA16(ka[kb][1], vf[1], sacc[kb]);
#pragma unroll
            for (int kb = 0; kb < 4; ++kb) sacc[kb] = sacc[kb] * dv[kb];
        }
        LBAR();
        {
            f32x4 o4[4]; float ss = 0.f;
#pragma unroll
            for (int q = 0; q < 4; ++q) { o4[q] = *(const LAS f32x4*)(L + G_O + et * G_OP + (16 * evc + 4 * q) * 4); ss += (o4[q][0] * o4[q][0] + o4[q][1] * o4[q][1]) + (o4[q][2] * o4[q][2] + o4[q][3] * o4[q][3]); }
            ss += __shfl_xor(ss, 1); ss += __shfl_xor(ss, 2); ss += __shfl_xor(ss, 4);
            const float rn = __builtin_amdgcn_rsqf(ss * (1.0f / 128.0f) + EPS);
#pragma unroll
            for (int i = 0; i < 2; ++i) {
                const f32x4 ga = {bflo(gg[i].x), bfhi(gg[i].x), bflo(gg[i].y), bfhi(gg[i].y)}, gb = {bflo(gg[i].z), bfhi(gg[i].z), bflo(gg[i].w), bfhi(gg[i].w)};
                const f32x4 ra = o4[2 * i] * rn * gw4[2 * i] * ga, rb = o4[2 * i + 1] * rn * gw4[2 * i + 1] * gb;
                outp[i] = pack8(ra, rb);
            }
        }
    }
#pragma unroll
    for (int i = 0; i < 2; ++i) *(v4u*)(MIX + (tokb + 64 * (size_t)(SEQ / 64 - 1) + et) * DM + DA + h * 128 + 16 * evc + 8 * i) = outp[i];
#undef GLA_LOAD
    float* so = (var ? WSP(float, (size_t)1300 * MiB) : F.out + OUT_SP) + ((size_t)(b * HB + h) * DKB) * DVB;
#pragma unroll
    for (int kb = 0; kb < 4; ++kb)
#pragma unroll
        for (int r = 0; r < 4; ++r) so[(size_t)(16 * kb + 4 * g + r) * DVB + 16 * w + i16] = sacc[kb][r];
    LBAR();
}

__device__ __forceinline__ void gla_sample_item(Frame& F, int b, int h) {
    int tid = F.tid; asm volatile("" : "+v"(tid));
    const int lane = tid & 63, w = __builtin_amdgcn_readfirstlane(tid >> 6);
    LAS float* LA = (LAS float*)(F.lds + RING_OFF);
    LAS float* LK = LA + 512; LAS float* LQ = LK + 512;
    LAS float* LV = LQ + 512;
    LAS float* LO = LV + 1024;
    const bf16* QBp = WSP(bf16, WS_QB); const bf16* KBp = WSP(bf16, WS_KB); const bf16* VBp = WSP(bf16, WS_VB); const bf16* GBp = WSP(bf16, WS_GB);
    const bf16* LOGA = WSP(bf16, WS_LOGA); bf16* MIX = WSP(bf16, WS_MIX);
    const size_t row0 = (size_t)MP + 8 * b;
    { const int t = tid >> 6, k = tid & 63; const size_t r = row0 + t;
      LA[tid] = fast_exp(bflo((unsigned)LOGA[r * 256 + h * 64 + k]));
      LK[tid] = bflo((unsigned)KBp[r * 256 + h * 64 + k]); LQ[tid] = bflo((unsigned)QBp[r * 256 + h * 64 + k]);
#pragma unroll
      for (int i = 0; i < 2; ++i) { const int e = tid + 512 * i, tt = e >> 7, v = e & 127; LV[e] = bflo((unsigned)VBp[(row0 + tt) * 512 + h * 128 + v]); } }
    const int v = tid & 127, kq = tid >> 7;
    const float* sin_ = INP(I_SG) + ((size_t)(b * HB + h) * DKB + 16 * kq) * DVB + v;
    float S[16];
#pragma unroll
    for (int i = 0; i < 16; ++i) S[i] = sin_[(size_t)i * DVB];
    LBAR();
#pragma unroll
    for (int t = 0; t < 8; ++t) {
        const float vt = LV[t * 128 + v]; float po = 0.f;
#pragma unroll
        for (int i = 0; i < 16; ++i) { const int k = 16 * kq + i; S[i] = LA[t * 64 + k] * S[i] + LK[t * 64 + k] * vt; po += LQ[t * 64 + k] * S[i]; }
        LO[(t * 4 + kq) * 128 + v] = po;
    }
    float* sout = F.out + OUT_SS + ((size_t)(b * HB + h) * DKB + 16 * kq) * DVB + v;
#pragma unroll
    for (int i = 0; i < 16; ++i) sout[(size_t)i * DVB] = S[i];
    LBAR();
    { const int t = w, v2 = 2 * lane;
      float o0 = 0.f, o1 = 0.f;
#pragma unroll
      for (int q = 0; q < 4; ++q) { const f32x2 p = *(const LAS f32x2*)(LO + (t * 4 + q) * 128 + v2); o0 += p.x; o1 += p.y; }
      const float ss = wave_sum(o0 * o0 + o1 * o1);
      const float rn = __builtin_amdgcn_rsqf(ss * (1.0f / 128.0f) + EPS);
      const unsigned gt = *(const unsigned*)(GBp + (row0 + t) * 512 + h * 128 + v2);
      const f32x2 gw = *(const f32x2*)(INP(I_GNW) + v2);
      *(unsigned*)(MIX + (row0 + t) * DM + DA + h * 128 + v2) = pk2(o0 * rn * gw.x * bflo(gt), o1 * rn * gw.y * bfhi(gt)); }
    LBAR();
}

__device__ __forceinline__ void attn_sample_item(Frame& F, int b, int h) {
    int tid = F.tid; asm volatile("" : "+v"(tid));
    const int lane = tid & 63, t = __builtin_amdgcn_readfirstlane(tid >> 6), g4 = lane >> 4, c = lane & 15;
    const bf16* Qp = WSP(bf16, WS_Q); const bf16* GAp = WSP(bf16, WS_GA); bf16* MIX = WSP(bf16, WS_MIX);
    const float mref = WSP(const float, WS_SCAL)[0];
    const size_t row = (size_t)MP + 8 * b + t;
    const v2u qraw = *(const v2u*)(Qp + row * DA + h * 64 + 4 * c);
    const f32x4 q = {bflo(qraw.x), bfhi(qraw.x), bflo(qraw.y), bfhi(qraw.y)};
    const float* cK = INP(I_CK) + ((size_t)b * WIN * HA + h) * HD + 4 * c; const float* cV = INP(I_CV) + ((size_t)b * WIN * HA + h) * HD + 4 * c;
    const float* nK = F.out + OUT_KNEW + ((size_t)b * ST * HA + h) * HD + 4 * c; const float* nV = F.out + OUT_VNEW + ((size_t)b * ST * HA + h) * HD + 4 * c;
    f32x4 o = {0.f, 0.f, 0.f, 0.f}; float l = 0.f;
#pragma unroll
    for (int di = 0; di < 3; ++di) {
        const int D = di == 0 ? 16 : (di == 1 ? 4 : 1);
#pragma unroll 1
        for (int it0 = 0; it0 < 32; it0 += 4) {
            f32x4 kv[4], vv[4];
#pragma unroll
            for (int u = 0; u < 4; ++u) {
                const int j = 4 * (it0 + u) + g4;
                const int idx = WIN + t - D * j;
                const bool fresh = idx >= WIN;
                const float* kp = fresh ? nK + (size_t)(idx - WIN) * (HA * HD) : cK + (size_t)idx * (HA * HD);
                const float* vp = fresh ? nV + (size_t)(idx - WIN) * (HA * HD) : cV + (size_t)idx * (HA * HD);
                kv[u] = *(const f32x4*)kp; vv[u] = *(const f32x4*)vp;
            }
#pragma unroll
            for (int u = 0; u < 4; ++u) {
                float d = (kv[u][0] * q[0] + kv[u][1] * q[1]) + (kv[u][2] * q[2] + kv[u][3] * q[3]);
                d += __shfl_xor(d, 1); d += __shfl_xor(d, 2); d += __shfl_xor(d, 4); d += __shfl_xor(d, 8);
                const float p = fast_exp2(d - mref);
                l += p; o += vv[u] * p;
            }
        }
        {
            const int idx = WIN + t - D * 128;
            const f32x4 kv = *(const f32x4*)(cK + (size_t)idx * (HA * HD)), vv = *(const f32x4*)(cV + (size_t)idx * (HA * HD));
            float d = (kv[0] * q[0] + kv[1] * q[1]) + (kv[2] * q[2] + kv[3] * q[3]);
            d += __shfl_xor(d, 1); d += __shfl_xor(d, 2); d += __shfl_xor(d, 4); d += __shfl_xor(d, 8);
            const float p = g4 == 0 ? fast_exp2(d - mref) : 0.f;
            l += p; o += vv * p;
        }
    }
#pragma unroll
    for (int j = 0; j < 4; ++j) { o[j] += __shfl_xor(o[j], 16); o[j] += __shfl_xor(o[j], 32); }
    l += __shfl_xor(l, 16); l += __shfl_xor(l, 32);
    if (g4 == 0) {
        const float rl = 1.0f / l;
        const v2u gr = *(const v2u*)(GAp + row * DA + h * 64 + 4 * c);
        v2u w_; w_.x = pk2(o[0] * rl * bflo(gr.x), o[1] * rl * bfhi(gr.x)); w_.y = pk2(o[2] * rl * bflo(gr.y), o[3] * rl * bfhi(gr.y));
        *(v2u*)(MIX + row * DM + h * 64 + 4 * c) = w_;
    }
}
constexpr int N_GLAP = NB * HB, N_ATTS = SB * HA, N_GLAS = SB * HB, N_ATTP = 3 * NB * HA * 4;
constexpr int T_ATTS = N_GLAP, T_GLAS = T_ATTS + N_ATTS, T_ATTP = T_GLAS + N_GLAS, T_TOTAL = T_ATTP + N_ATTP;
constexpr int SLOT_K = 16384, RING_V = 65536;
struct AItem { int b, h, g, x, nsteps; };
struct AStep { int b, h, g, D, r, kb, compute, valid; };
__device__ __forceinline__ AItem aitem_decode(int idx, int var = 0) {
    AItem a; const int bh = idx / 12, sub = idx - 12 * bh; a.g = sub >> 2;
#ifdef PROBE_VARIANTS
    if (var >= 1 && var <= 3) a.g = var - 1;
#endif
    a.b = bh >> 3; a.h = bh & 7; a.x = sub & 3; a.nsteps = 8 + ((a.g == 2 && a.x > 0) ? 1 : 0); return a;
}
__device__ __forceinline__ AStep astep(const AItem& it, int k) {
    AStep s; s.b = it.b; s.h = it.h; s.g = it.g; s.valid = 1; s.compute = 1;
    if (it.g == 0) { s.D = 16; s.r = 4 * it.x + (k >> 1); s.kb = k & 1; }
    else if (it.g == 1) { s.D = 4; s.r = it.x; s.kb = k; }
    else { const int pre = it.x > 0 ? 1 : 0; s.D = 1; s.r = 0; s.kb = 8 * it.x - pre + k; s.compute = (pre && k == 0) ? 0 : 1; }
    return s;
}
__device__ __forceinline__ AStep astep2(const AItem& cur, const AItem& nxt, bool has_nxt, int k_rel) {
    if (k_rel < cur.nsteps) return astep(cur, k_rel);
    if (has_nxt) return astep(nxt, k_rel - cur.nsteps);
    AStep s = astep(cur, 0); s.valid = 0; s.compute = 0; return s;
}
__device__ __forceinline__ void glds16(const void* gsrc, unsigned lds_dst) { unsigned keep;
    asm volatile("s_mov_b32 %0, m0\n\ts_mov_b32 m0, %2\n\ts_nop 0\n\tglobal_load_lds_dwordx4 %1, off\n\ts_mov_b32 m0, %0" : "=&s"(keep) : "v"(gsrc), "s"(lds_dst) : "memory"); }
__device__ __forceinline__ void att_dma_slot(Frame& F, const AStep& st, int slot, int w, int lane) {
    const bf16* Kp = WSP(bf16, WS_K); const bf16* Vp = WSP(bf16, WS_V);
    LAS unsigned char* sb = F.lds + RING_OFF + slot * SLOT_K;
    const size_t rowb = (size_t)st.b * SEQ + st.r; const int m0 = 128 * st.kb;
#pragma unroll
    for (int e = 0; e < 2; ++e) {
        const int key = 16 * w + 8 * e + (lane >> 3), p = lane & 7; const size_t row = rowb + (size_t)(m0 + key) * st.D;
        glds16(Kp + row * DA + st.h * 64 + (p ^ ((key >> 1) & 7)) * 8, (unsigned)__builtin_amdgcn_readfirstlane((int)(unsigned)(__UINTPTR_TYPE__)(sb + (16 * w + 8 * e) * 128)));
        glds16(Vp + row * DA + st.h * 64 + (p ^ (2 * ((key >> 1) & 3))) * 8, (unsigned)__builtin_amdgcn_readfirstlane((int)(unsigned)(__UINTPTR_TYPE__)(sb + RING_V + (16 * w + 8 * e) * 128)));
    }
}
__device__ __forceinline__ int crow(int r, int hi) { return (r & 3) + 8 * (r >> 2) + 4 * hi; }
__device__ __forceinline__ void q_load2(v4u (&q)[2], const bf16* p) {
    asm volatile("global_load_dwordx4 %0, %2, off\n\tglobal_load_dwordx4 %1, %2, off offset:64" : "=&v"(q[0]), "=&v"(q[1]) : "v"(p) : "memory");
}
#define WAITV_CASE(n) case n: asm volatile("s_waitcnt vmcnt(" #n ")" : "+v"(dep) :: "memory"); break;
__device__ __forceinline__ void wait_vm(int n, unsigned& dep) {
    switch (n) { WAITV_CASE(2) WAITV_CASE(3) WAITV_CASE(4) WAITV_CASE(5) WAITV_CASE(6) WAITV_CASE(7) WAITV_CASE(8) WAITV_CASE(9) WAITV_CASE(10) WAITV_CASE(11) default: asm volatile("s_waitcnt vmcnt(0)" : "+v"(dep) :: "memory"); }
}
template <bool FIRST, bool WRAP>
__device__ __forceinline__ void att_compute(const LAS unsigned char* ring, int prev, const bf16x8 (&qf)[2], float mref, int qw, int lane, f32x4 (&o)[4], f32x4& lacc, int pv = 0) {
    const int ql = lane & 15, g = lane >> 4, i16 = lane & 15;
    const int ksw = (ql >> 1) & 7;
    const int koff0 = ql * 128 + ((g ^ ksw) * 16), koff1 = ql * 128 + (((4 + g) ^ ksw) * 16);
    const int vrowl = 4 * g + (i16 >> 2), vsw = 2 * ((vrowl >> 1) & 3), vpc = (i16 & 3) >> 1;
    const int voff = vrowl * 128 + (i16 & 1) * 8;
#define ATT_ROWB(kw) (WRAP ? ((((kw) < 128) ? 3 * 128 + (kw) : (kw) - 128) * 128) : ((prev * 128 + (kw)) * 128))
    const LAS unsigned char* kb0 = ring + koff0; const LAS unsigned char* kb1 = ring + koff1; const LAS unsigned char* vb = ring + RING_V + voff;
    const LAS unsigned char* vbd[4];
#pragma unroll
    for (int dt = 0; dt < 4; ++dt) vbd[dt] = vb + (((2 * dt + vpc) ^ vsw) * 16);
    const int wb = WRAP ? 0 : (prev * 128 + 16 * qw) * 128;
    f32x4 st[9];
#pragma unroll
    for (int t = 0; t < 9; ++t) {
        const int rb = WRAP ? ATT_ROWB(16 * (qw + t)) : wb + t * 2048;
        const bf16x8 a0 = *(const LAS bf16x8*)(kb0 + rb), a1 = *(const LAS bf16x8*)(kb1 + rb);
        f32x4 c = {-mref, -mref, -mref, -mref};
        c = MFMA16(a0, qf[0], c); st[t] = MFMA16(a1, qf[1], c);
    }
    s16x4 va[2][4][2];
#define ATT_VLOAD(u, buf) do { const int r0_ = WRAP ? ATT_ROWB(16 * (qw + 2 * (u))) : wb + 2 * (u) * 2048; \
        const int r1_ = ((u) < 4) ? (WRAP ? ATT_ROWB(16 * (qw + 2 * (u) + 1)) : wb + (2 * (u) + 1) * 2048) : r0_; \
        _Pragma("unroll") for (int dt = 0; dt < 4; ++dt) { va[buf][dt][0] = tr16(vbd[dt] + r0_); va[buf][dt][1] = tr16(vbd[dt] + r1_); } } while (0)
    ATT_VLOAD(0, 0);
#pragma unroll
    for (int t = 0; t < 9; ++t) {
#pragma unroll
        for (int r = 0; r < 4; ++r) {
            float p = fast_exp2(st[t][r]);
            if (t == 0) { if (4 * g + r < ql) p = 0.f; }
            if (t == 8) { if (4 * g + r > ql) p = 0.f; }
            if (FIRST) { if (qw + t < 8) p = 0.f; }
            st[t][r] = p;
        }
    }
    const v4u one4 = {0x3F803F80u, 0x3F803F80u, 0x3F803F80u, 0x3F803F80u}; const bf16x8 ones = __builtin_bit_cast(bf16x8, one4);
#pragma unroll
    for (int u = 0; u < 5; ++u) {
        if (u < 4) ATT_VLOAD(u + 1, (u + 1) & 1);
        __builtin_amdgcn_sched_barrier(0);
        const f32x4 z = {0.f, 0.f, 0.f, 0.f};
        const bf16x8 pb = pk8(st[2 * u], (u < 4) ? st[2 * u + 1] : z);
#pragma unroll
        for (int dt = 0; dt < 4; ++dt) o[dt] = MFMA16(cat8(va[u & 1][dt][0], va[u & 1][dt][1]), pb, o[dt]);
        lacc = MFMA16(ones, pb, lacc);
        __builtin_amdgcn_sched_barrier(0);
    }
#undef ATT_VLOAD
#undef ATT_ROWB
}
__device__ __forceinline__ void att_q_dma(Frame& F, const AStep& st, int w, int lane) {
    const bf16* Qp = WSP(bf16, WS_Q);
    LAS unsigned char* T = F.lds + OSTAGE_OFF + w * 2048;
#pragma unroll
    for (int e = 0; e < 2; ++e) {
        const int rr = lane >> 3, q = 16 * w + 8 * e + rr, p = (lane & 7) ^ rr;
        const size_t row = (size_t)st.b * SEQ + (size_t)(128 * st.kb + q) * st.D + st.r;
        glds16(Qp + row * DA + st.h * 64 + p * 8, (unsigned)__builtin_amdgcn_readfirstlane((int)(unsigned)(__UINTPTR_TYPE__)(T + e * 1024)));
    }
}
__device__ __forceinline__ void attn_prompt_loop(Frame& F, int t) {
    int tid_ = F.tid; asm volatile("" : "+v"(tid_));
    const int lane = tid_ & 63, w = __builtin_amdgcn_readfirstlane(tid_ >> 6), ql = lane & 15, g4 = lane >> 4;
    bf16* OP = WSP(bf16, WS_OPART); float* LP = WSP(float, WS_LPART);
    const float mref = WSP(const float, WS_SCAL)[0];
    const LAS unsigned char* L = F.lds + RING_OFF;
    LAS unsigned char* stg = F.lds + OSTAGE_OFF + w * 2048;
    const int qoff0 = ql * 128 + ((g4 ^ (ql & 7)) << 4), qoff1 = ql * 128 + (((4 + g4) ^ (ql & 7)) << 4);
    { LAS v4u* z = (LAS v4u*)(F.lds + RING_OFF + RING_V + 3 * SLOT_K); z[tid_] = (v4u){0u, 0u, 0u, 0u}; z[tid_ + 512] = (v4u){0u, 0u, 0u, 0u}; }
    const int avar = F.item_mask >> 8;
    AItem cur = aitem_decode(t - T_ATTP, avar), nxt = cur; bool has_nxt = false;
    int k = 0, sc = 0;
    AStep st = astep(cur, 0);
    att_q_dma(F, st, w, lane);
    att_dma_slot(F, st, 0, w, lane);
    const AStep s1 = astep(cur, 1);
    att_dma_slot(F, s1, 1, w, lane);
    unsigned dep0 = 0u;
    wait_vm(8, dep0);
    v4u qn[2]; qn[0] = *(const LAS v4u*)(stg + qoff0); qn[1] = *(const LAS v4u*)(stg + qoff1);
    LDS_WAIT();
    att_q_dma(F, s1, w, lane);
    bool d0 = true, d1 = true, first = true, h2 = false;
    unsigned tkt = 0u;
    v4u ost[2] = {}; float lst = 0.f; bf16* ostp = nullptr; float* lstp = nullptr; bool have_st = false;
    for (;;) {
        if (first) wait_vm(6, dep0); else wait_vm((d0 ? 2 : 0) + (d1 ? 6 : 0) + (h2 ? 3 : 0), dep0);
        LBAR();
        first = false;
        const bool h1 = have_st;
        if (have_st) {
            *(v4u*)(ostp) = ost[0]; *(v4u*)(ostp + 32) = ost[1];
            if (g4 == 0) *lstp = lst;
            have_st = false;
        }
        if (k == 0 && tid_ == 0) { const unsigned one_ = 1u; asm volatile("global_atomic_add %0, %1, %2, off sc0" : "=&v"(tkt) : "v"(F.ctl + CW_TICKET), "v"(one_) : "memory"); }
        if (k == 2 && tid_ == 0) { asm volatile("" : "+v"(tkt)); F.MISC[4] = tkt; }
        if (k == 3) { const int tn = __builtin_amdgcn_readfirstlane((int)F.MISC[4]); has_nxt = tn < T_TOTAL; if (has_nxt) nxt = aitem_decode(tn - T_ATTP, avar); }
        const AStep s2 = astep2(cur, nxt, has_nxt, k + 2);
        const bool d2 = s2.valid != 0;
        if (d2) att_dma_slot(F, s2, (sc + 2) & 3, w, lane);
        bf16x8 qf[2];
#pragma unroll
        for (int d0_ = 0; d0_ < 2; ++d0_) qf[d0_] = __builtin_bit_cast(bf16x8, qn[d0_]);
        f32x4 o[4]; f32x4 lacc = {0.f, 0.f, 0.f, 0.f};
#pragma unroll
        for (int dt = 0; dt < 4; ++dt) o[dt] = (f32x4){0.f, 0.f, 0.f, 0.f};
        if (st.compute) {
            const int prev = (sc + 3) & 3;
            if (prev == 3) { if (st.kb == 0) att_compute<true, true>(L, prev, qf, mref, w, lane, o, lacc, avar); else att_compute<false, true>(L, prev, qf, mref, w, lane, o, lacc, avar); }
            else { if (st.kb == 0) att_compute<true, false>(L, prev, qf, mref, w, lane, o, lacc, avar); else att_compute<false, false>(L, prev, qf, mref, w, lane, o, lacc, avar); }
        }
        { unsigned dp = __builtin_bit_cast(unsigned, lacc[0]); wait_vm((d2 ? 4 : 0) + (h1 ? 3 : 0), dp); lacc[0] = __builtin_bit_cast(float, dp); }
        qn[0] = *(const LAS v4u*)(stg + qoff0); qn[1] = *(const LAS v4u*)(stg + qoff1);
        if (st.compute) {
#pragma unroll
            for (int u = 0; u < 4; ++u) { v2u x; x.x = pk2(o[u][0], o[u][1]); x.y = pk2(o[u][2], o[u][3]); *(LAS v2u*)(stg + ql * 128 + (16 * u + 4 * g4) * 2) = x; }
            LDS_WAIT();
            const int sq = lane >> 2, sp = lane & 3;
            ost[0] = *(const LAS v4u*)(stg + sq * 128 + sp * 16); ost[1] = *(const LAS v4u*)(stg + sq * 128 + 64 + sp * 16);
            const size_t qrow = (size_t)st.b * SEQ + (size_t)(128 * st.kb + 16 * w + sq) * st.D + st.r;
            ostp = OP + (size_t)st.g * OPART_STRIDE + qrow * DA + st.h * 64 + sp * 8;
            const size_t lrow = (size_t)st.b * SEQ + (size_t)(128 * st.kb + 16 * w + ql) * st.D + st.r;
            lstp = LP + (size_t)st.g * LPART_STRIDE + lrow * HA + st.h;
            lst = lacc[0];
            have_st = true;
        }
        LDS_WAIT();
        if (d2) att_q_dma(F, s2, w, lane);
        ++sc; ++k; d0 = d1; d1 = d2; h2 = h1;
        if (k == cur.nsteps) { if (!has_nxt) break; cur = nxt; has_nxt = false; k = 0; }
        st = astep(cur, k);
    }
    if (have_st) {
        *(v4u*)(ostp) = ost[0]; *(v4u*)(ostp + 32) = ost[1];
        if (g4 == 0) *lstp = lst;
    }
    VM_WAIT(); LBAR();
}
__device__ __forceinline__ int p2_fetch(Frame& F) {
    if (F.tid == 0) F.MISC[4] = __hip_atomic_fetch_add(F.ctl + CW_TICKET, 1u, RLX_AGENT);
    LBAR(); const int t = __builtin_amdgcn_readfirstlane((int)F.MISC[4]); LBAR(); return t;
}
__device__ __forceinline__ void p2_phase(Frame& F) {
    int t = p2_fetch(F);
    while (t < T_TOTAL) {
#ifndef ONLY_ITEM
#define ONLY_ITEM -1
#endif
        if (t < T_ATTS) { if ((ONLY_ITEM < 0 || ONLY_ITEM == 0) && (F.item_mask & 1)) gla_prompt_item(F, t >> 2, t & 3); }
        else if (t < T_GLAS) { const int i = t - T_ATTS; if ((ONLY_ITEM < 0 || ONLY_ITEM == 1) && (F.item_mask & 2)) attn_sample_item(F, i >> 3, i & 7); }
        else if (t < T_ATTP) { const int i = t - T_GLAS; if ((ONLY_ITEM < 0 || ONLY_ITEM == 2) && (F.item_mask & 4)) gla_sample_item(F, i >> 2, i & 3); }
        else { if ((ONLY_ITEM < 0 || ONLY_ITEM == 3) && (F.item_mask & 8)) attn_prompt_loop(F, t); break; }
        t = p2_fetch(F);
    }
}
struct OneUnit { int pm, pn;
    __device__ __forceinline__ bool next(int i, pg8::Unit& u) const { if (i > 0) return false; u.pm = pm; u.pn = pn; return true; }
    __device__ __forceinline__ void a_ready(const pg8::Unit&) const {}
    __device__ __forceinline__ void done(const pg8::Unit&) const {} };
constexpr int N_SU_IN = (MS / 256) * (NIN / 256), N_SU_OUT = (MS / 256) * (DM / 256);
__device__ __forceinline__ void p2b_combine(Frame& F) {
    const bf16* OP = WSP(bf16, WS_OPART); const float* LP = WSP(float, WS_LPART); const bf16* GAp = WSP(bf16, WS_GA); bf16* MIX = WSP(bf16, WS_MIX);
    const size_t gt = (size_t)(blockIdx.x - N_SU_OUT) * (NWAVES * 64) + F.tid, NGT = (size_t)(F.G - N_SU_OUT) * NWAVES * 64;
    constexpr size_t NIT = (size_t)MP * 64;
    for (size_t it = gt; it < NIT; it += 2 * NGT) {
        const size_t itb = it + NGT; const bool hasb = itb < NIT; const size_t i2 = hasb ? itb : it;
        const size_t tok[2] = {it >> 6, i2 >> 6}; const int c8[2] = {(int)(it & 63), (int)(i2 & 63)};
        v4u x[2][3], gx[2]; float lv[2][3];
#pragma unroll
        for (int e = 0; e < 2; ++e) {
#pragma unroll
            for (int g = 0; g < 3; ++g) { x[e][g] = NTLD((const v4u*)(OP + (size_t)g * OPART_STRIDE + tok[e] * DA + 8 * c8[e])); lv[e][g] = LP[(size_t)g * LPART_STRIDE + tok[e] * HA + (c8[e] >> 3)]; }
            gx[e] = NTLD((const v4u*)(GAp + tok[e] * DA + 8 * c8[e]));
        }
#pragma unroll
        for (int e = 0; e < 2; ++e) {
            if (e == 1 && !hasb) continue;
            f32x4 a = {0.f, 0.f, 0.f, 0.f}, b = {0.f, 0.f, 0.f, 0.f}; float l = 0.f;
#pragma unroll
            for (int g = 0; g < 3; ++g) { a += (f32x4){bflo(x[e][g].x), bfhi(x[e][g].x), bflo(x[e][g].y), bfhi(x[e][g].y)}; b += (f32x4){bflo(x[e][g].z), bfhi(x[e][g].z), bflo(x[e][g].w), bfhi(x[e][g].w)}; l += lv[e][g]; }
            const float rl = 1.0f / l;
            a = a * rl * (f32x4){bflo(gx[e].x), bfhi(gx[e].x), bflo(gx[e].y), bfhi(gx[e].y)}; b = b * rl * (f32x4){bflo(gx[e].z), bfhi(gx[e].z), bflo(gx[e].w), bfhi(gx[e].w)};
            *(v4u*)(MIX + tok[e] * DM + 8 * c8[e]) = pack8(a, b);
        }
    }
}

__device__ __forceinline__ void stagger_start(int c, int n_long, int G, unsigned span_ticks) {
    if (c < n_long || span_ticks == 0u) return;
    const unsigned frac = (unsigned)(((c - n_long) * 97) % (G - n_long));
    const unsigned long long wait = (unsigned long long)span_ticks * frac / (unsigned)(G - n_long), t0 = __builtin_amdgcn_s_memrealtime();
    while (__builtin_amdgcn_s_memrealtime() - t0 < wait) __builtin_amdgcn_s_sleep(16);
}
#ifndef STAG1
#define STAG1 0
#endif
#ifndef STAG3
#define STAG3 0
#endif
#ifndef MK_N_LAUNCHES
#define MK_N_LAUNCHES 6
#endif
constexpr int N_PHASES = 6;
__global__ void __launch_bounds__(NWAVES * 64, 2) hymba_fwd(Args args) {
    extern __shared__ __attribute__((aligned(16))) unsigned char lds[];
    Frame F;
    F.lds = (LAS unsigned char*)lds; F.MISC = (volatile LAS unsigned*)(F.lds + MISC_OFF);
    F.tid = threadIdx.x; F.lane = F.tid & 63; F.wave = __builtin_amdgcn_readfirstlane(F.tid >> 6); F.G = gridDim.x;
    F.item_mask = args.item_mask; F.ws = args.ws; F.ctl = (gu32*)(args.ws + WS_CTL); F.out = args.out;
    for (int u = F.tid; u < (LDS_BYTES - LDSCTL_OFF) / 4; u += NWAVES * 64) ((LAS unsigned*)(F.lds + LDSCTL_OFF))[u] = 0u;
    __syncthreads();
    const int lo = args.ph_lo, hi = args.ph_hi;
    XcdBarrier bar; bar.bar = (unsigned*)(F.ctl + CW_BAR); bar.x = 0; bar.st = nullptr;
    if (hi - lo > 1) bar = xcd_barrier_post((unsigned*)(F.ctl + CW_BAR), F.MISC + 8);
#ifdef ONLY_PHASE
#define IN(k) ((k) == ONLY_PHASE && lo <= (k) && (k) < hi)
#else
#define IN(k) (lo <= (k) && (k) < hi)
#endif
#define BOTH(k) (IN(k) && IN((k) + 1))
    if (IN(0)) {
        p0_prologue(F);
        asm volatile("s_waitcnt vmcnt(0)" ::: "memory"); __syncthreads();
        if (F.tid == 0) { __builtin_amdgcn_fence(__ATOMIC_RELEASE, "agent"); asm volatile("s_waitcnt vmcnt(0)" ::: "memory"); __hip_atomic_fetch_add(F.ctl + CW_P0A, 1u, RLX_AGENT); }
        if (!IN(1) && BOTH(0)) xcd_barrier(bar);
    }
    if (IN(1)) {
        if ((int)blockIdx.x < N_SU_IN) {
            if (IN(0)) {
                if (F.tid == 0) {
                    unsigned sp = 0; bool ok = true;
                    while (__hip_atomic_load(F.ctl + CW_P0A, RLX_AGENT) < (unsigned)F.G) { __builtin_amdgcn_s_sleep(8); if (++sp > (1u << 22)) { ok = false; break; } }
                    if (!ok) __hip_atomic_store(F.ctl + CW_TMO, 1u, RLX_AGENT);
                    __builtin_amdgcn_fence(__ATOMIC_ACQUIRE, "agent"); asm volatile("s_waitcnt vmcnt(0)" ::: "memory");
                }
                __syncthreads();
                __builtin_amdgcn_fence(__ATOMIC_ACQUIRE, "agent"); asm volatile("s_waitcnt vmcnt(0)" ::: "memory");
            }
            pg8::Gemm g{WSP(const pg8::bf16_t, WS_XB), WSP(const pg8::bf16_t, WS_WIN), MTOT, NIN, DM}; OneUnit S{MP / 256 + (int)blockIdx.x / (NIN / 256), (int)blockIdx.x % (NIN / 256)};
            EpiIn E{WSP(const float, WS_RSTD), WSP(const float, WS_ROPE), WSP(const float, WS_SCAL) + 64, INP(I_BGATE), F.ws, F.out, F.lds + OSTAGE_OFF};
            pg8::gemm_phase<EpiIn, OneUnit, false, true>(F.lds + RING_OFF, g, S, E);
        }
        p0b_convert(F);
        if (BOTH(1)) xcd_barrier(bar);
    }
    if (IN(2)) {
        pg8::Gemm g{WSP(const pg8::bf16_t, WS_XB), WSP(const pg8::bf16_t, WS_WIN), MP, NIN, DM}; pg8::StaticOrder S; S.init(MP, NIN, F.G, (int)blockIdx.x);
        EpiIn E{WSP(const float, WS_RSTD), WSP(const float, WS_ROPE), WSP(const float, WS_SCAL) + 64, INP(I_BGATE), F.ws, F.out, F.lds + OSTAGE_OFF};
        stagger_start((int)blockIdx.x, (MP / 256) * (NIN / 256) % F.G, F.G, STAG1);
        pg8::gemm_phase<EpiIn, pg8::StaticOrder, true, true>(F.lds + RING_OFF, g, S, E);
        if (BOTH(2)) xcd_barrier(bar);
    }
    if (IN(3)) { p2_phase(F); if (BOTH(3)) xcd_barrier(bar); }
    if (IN(4)) {
        if ((int)blockIdx.x < N_SU_OUT) {
            pg8::Gemm g{WSP(const pg8::bf16_t, WS_MIX), WSP(const pg8::bf16_t, WS_WOUT), MTOT, DM, DM}; OneUnit S{MP / 256 + (int)blockIdx.x / (DM / 256), (int)blockIdx.x % (DM / 256)};
            EpiOut E{WSP(const bf16, WS_XB), F.out, F.lds + OSTAGE_OFF};
            pg8::gemm_phase<EpiOut, OneUnit, false, true>(F.lds + RING_OFF, g, S, E);
        } else p2b_combine(F);
        if (BOTH(4)) xcd_barrier(bar);
    }
    if (IN(5)) {
        pg8::Gemm g{WSP(const pg8::bf16_t, WS_MIX), WSP(const pg8::bf16_t, WS_WOUT), MP, DM, DM}; pg8::StaticOrder S; S.init(MP, DM, F.G, (int)blockIdx.x);
        EpiOut E{WSP(const bf16, WS_XB), F.out, F.lds + OSTAGE_OFF};
        stagger_start((int)blockIdx.x, (MP / 256) * (DM / 256) % F.G, F.G, STAG3);
        pg8::gemm_phase<EpiOut, pg8::StaticOrder, true, true>(F.lds + RING_OFF, g, S, E);
    }
#undef IN
#undef BOTH
}

extern "C" void kernel_launch(void* const* d_in, const int* in_sizes, int n_in, void* d_out, int out_size, void* d_ws, size_t ws_size, hipStream_t stream) {
    static int grid = 0;
    if (grid == 0) {
        if (n_in != 13 || (size_t)out_size != OUT_END || ws_size < WS_END) { fprintf(stderr, "kernel_launch: unexpected shapes (n_in %d out %d ws %zu)\n", n_in, out_size, ws_size); grid = -1; return; }
        int dev = 0, cus = 0, per_cu = 0;
        if (hipGetDevice(&dev) != hipSuccess || hipDeviceGetAttribute(&cus, hipDeviceAttributeMultiprocessorCount, dev) != hipSuccess) { grid = -1; return; }
        if (hipFuncSetAttribute((const void*)hymba_fwd, hipFuncAttributeMaxDynamicSharedMemorySize, LDS_BYTES) != hipSuccess) { fprintf(stderr, "kernel_launch: hipFuncSetAttribute failed\n"); grid = -1; return; }
        if (hipOccupancyMaxActiveBlocksPerMultiprocessor(&per_cu, (const void*)hymba_fwd, NWAVES * 64, LDS_BYTES) != hipSuccess || per_cu < 1) fprintf(stderr, "kernel_launch: occupancy query reports %d\n", per_cu);
        (void)hipGetLastError();
        grid = cus;
    }
    if (grid < 0) return;
    if (hipMemsetAsync((char*)d_ws + WS_CTL, 0, CTL_ZERO_BYTES, stream) != hipSuccess) return;
    Args a{};
    for (int i = 0; i < 13; ++i) a.in[i] = (const float*)d_in[i];
    a.out = (float*)d_out; a.ws = (unsigned char*)d_ws; a.item_mask = 15;
    constexpr int NL = MK_N_LAUNCHES;
    static_assert(NL == 1 || NL == N_PHASES, "MK_N_LAUNCHES is 1 or 6");
    for (int li = 0; li < NL; ++li) {
        a.ph_lo = (NL == 1) ? 0 : li; a.ph_hi = (NL == 1) ? N_PHASES : li + 1;
        hipLaunchKernelGGL(hymba_fwd, dim3(grid), dim3(NWAVES * 64), LDS_BYTES, stream, a);
        const hipError_t le = hipPeekAtLastError();
        if (le != hipSuccess) { fprintf(stderr, "kernel_launch: launch %d failed: %s\n", li, hipGetErrorName(le)); break; }
    }
#ifdef PROBE_EXTRA_PHASE
    (void)hipMemsetAsync((char*)d_ws + WS_CTL, 0, CTL_ZERO_BYTES, stream);
    a.ph_lo = PROBE_EXTRA_PHASE; a.ph_hi = PROBE_EXTRA_PHASE + 1;
#ifdef PROBE_ITEM_MASK
    a.item_mask = PROBE_ITEM_MASK;
#endif
    hipLaunchKernelGGL(hymba_fwd, dim3(grid), dim3(NWAVES * 64), LDS_BYTES, stream, a);
#endif
}
```

```cpp
#include <hip/hip_runtime.h>
#include <cstdio>
#include <cstdint>
#include <cmath>
#define MK_N_LAUNCHES 1
namespace pg8 {
#define PG8_LAS __attribute__((address_space(3)))
typedef unsigned short bf16_t;
typedef short bf16x8 __attribute__((ext_vector_type(8)));
typedef float f32x4 __attribute__((ext_vector_type(4)));
typedef unsigned u32x4 __attribute__((ext_vector_type(4)));
constexpr int BM = 256, BK = 64, HALF = 128, HTB = HALF * BK * 2  , STAGE_BYTES = 8 * HTB, NXCD = 8, WGM = 8;

__host__ __device__ __forceinline__ int lds_byte(int r, int c) { const int st = (r >> 4) * 2 + (c >> 5), rr = r & 15, cc = c & 31, ob = rr * 64 + cc * 2; return st * 1024 + (ob ^ (((ob >> 9) & 1) << 5)); }
__host__ __device__ __forceinline__ void stage_rc(int b, int& R, int& C) { const int st = b / 1024, sb = b % 1024, swz = sb ^ (((sb >> 9) & 1) << 5); R = (st >> 1) * 16 + swz / 64; C = (st & 1) * 32 + (swz % 64) / 2; }
__host__ __device__ __forceinline__ int perm32(int rho) { const int n = rho >> 4, i = rho & 15; return 8 * (i >> 2) + 4 * n + (i & 3); }

struct Unit { int pm, pn; };
struct Gemm { const bf16_t* A; const bf16_t* Bt; int M, N, K; };

struct StaticOrder {
    int nM, nN, nwg, G, c, swp;
    __host__ __device__ void init(int M, int N, int G_, int c_, int swp_ = 0) { nM = M / BM; nN = N / BM; nwg = nM * nN; G = G_; c = c_; swp = swp_; }
    __host__ __device__ bool next(int i, Unit& u) const {
        const long L = (long)i * G + c; if (L >= nwg) return false;
        int wgid = (int)L; { const int q = nwg / NXCD, r = nwg % NXCD, xcd = wgid % NXCD, off = wgid / NXCD; wgid = (xcd < r ? xcd * (q + 1) : r * (q + 1) + (xcd - r) * q) + off; }
        const int nig = WGM * nN, gid = (wgid / nig) ^ (swp & c & 1), fm = gid * WGM, gsz = (nM - fm) < WGM ? (nM - fm) : WGM;
        u.pm = fm + ((wgid % nig) % gsz); u.pn = ((wgid % nig) / gsz + 2 * (c & 7)) % nN; return true;
    }
    __device__ __forceinline__ void a_ready(const Unit&) const {}
    __device__ __forceinline__ void done(const Unit&) const {}
};

__device__ __forceinline__ unsigned cvt_pk_bf16(float lo, float hi) { unsigned r; asm volatile("v_cvt_pk_bf16_f32 %0, %1, %2" : "=v"(r) : "v"(lo), "v"(hi)); return r; }
template <class Epi, class Sched, bool ALIGN_EPI = false, bool SP2 = false>
__device__ __forceinline__ void gemm_phase(PG8_LAS unsigned char* lds, const Gemm g, const Sched& S, const Epi& E) {
    const int tid = threadIdx.x, wid = __builtin_amdgcn_readfirstlane(tid >> 6), lane = tid & 63, wr = wid >> 2, wc = wid & 3, fr = lane & 15, fq = lane >> 4;
    const int K = g.K, nt = K / BK;
    unsigned voffA[2], voffB[2];
#pragma unroll
    for (int i = 0; i < 2; ++i) { int R, C; stage_rc(tid * 16 + i * 8192, R, C); const int Rb = Epi::PERM ? ((R & ~31) + perm32(R & 31)) : R;
        voffA[i] = (unsigned)(R * K + C) * 2u; voffB[i] = (unsigned)(Rb * K + C) * 2u; }
    const size_t kstep = (size_t)(BK * 2);
    const size_t hstep = (size_t)HALF * K * 2;
    const size_t tstep = 2 * hstep;
    const unsigned ldsw = (unsigned)wid * 1024u;
    const int aoff = lds_byte(wr * 64 + fr, fq * 8), boff = lds_byte(wc * 32 + fr, fq * 8);
#define PG8_SA(b, h) (((b) * 2 + (h)) * HTB)
#define PG8_SB(b, h) ((4 + (b) * 2 + (h)) * HTB)
#define PG8_STAGE(bufoff, gbase, voff) do { _Pragma("unroll") for (int _i = 0; _i < 2; ++_i) \
        __builtin_amdgcn_global_load_lds((const unsigned*)((const char*)(gbase) + (voff)[_i]), (PG8_LAS unsigned*)(lds + (bufoff) + ldsw + _i * 8192), 16, 0, 0); } while (0)
#define PG8_LDA(dst, b, h) do { _Pragma("unroll") for (int m = 0; m < 4; ++m) _Pragma("unroll") for (int k = 0; k < 2; ++k) dst[m][k] = *(const PG8_LAS bf16x8*)(lds + PG8_SA(b, h) + aoff + m * 2048 + k * 1024); } while (0)
#define PG8_LDB(dst, b, h) do { _Pragma("unroll") for (int n = 0; n < 2; ++n) _Pragma("unroll") for (int k = 0; k < 2; ++k) dst[n][k] = *(const PG8_LAS bf16x8*)(lds + PG8_SB(b, h) + boff + n * 2048 + k * 1024); } while (0)
#define PG8_MMA(ai, bj, At, Bt) do { __builtin_amdgcn_s_setprio(1); _Pragma("unroll") for (int m = 0; m < 4; ++m) _Pragma("unroll") for (int n = 0; n < 2; ++n) _Pragma("unroll") for (int k = 0; k < 2; ++k) \
        acc[ai][bj][m][n] = __builtin_amdgcn_mfma_f32_16x16x32_bf16(Bt[n][k], At[m][k], acc[ai][bj][m][n], 0, 0, 0); __builtin_amdgcn_s_setprio(0); } while (0)
#define PG8_WAIT_V(n) asm volatile("s_waitcnt vmcnt(" #n ")" ::: "memory")
#define PG8_WAIT_L(n) asm volatile("s_waitcnt lgkmcnt(" #n ")" ::: "memory")
#define PG8_BAR __builtin_amdgcn_s_barrier()
#define PG8_SCHED __builtin_amdgcn_sched_barrier(0)
    Unit cur, nxt; int ui = 0;
    if (!S.next(0, cur)) return;
    f32x4 acc[2][2][4][2];
#pragma unroll
    for (int a = 0; a < 2; ++a)
#pragma unroll
        for (int b = 0; b < 2; ++b)
#pragma unroll
            for (int m = 0; m < 4; ++m)
#pragma unroll
                for (int n = 0; n < 2; ++n) acc[a][b][m][n] = (f32x4){0.f, 0.f, 0.f, 0.f};
    bf16x8 At[4][2], B0[2][2], B1[2][2];
    const char* cA = (const char*)g.A + (size_t)cur.pm * tstep; const char* cB = (const char*)g.Bt + (size_t)cur.pn * tstep;
    S.a_ready(cur);
    if constexpr (SP2) {
        PG8_STAGE(PG8_SB(0, 0), cB, voffB); PG8_STAGE(PG8_SB(0, 1), cB + hstep, voffB); PG8_STAGE(PG8_SA(0, 0), cA, voffA); PG8_STAGE(PG8_SA(0, 1), cA + hstep, voffA);
        if (wr == 1) PG8_BAR;
        PG8_WAIT_V(2); PG8_BAR;
        PG8_STAGE(PG8_SB(1, 0), cB + kstep, voffB); PG8_STAGE(PG8_SA(1, 0), cA + kstep, voffA); PG8_STAGE(PG8_SB(1, 1), cB + hstep + kstep, voffB);
        PG8_WAIT_V(6); PG8_BAR;
    } else {
        PG8_STAGE(PG8_SB(0, 0), cB, voffB); PG8_STAGE(PG8_SA(0, 0), cA, voffA); PG8_STAGE(PG8_SB(0, 1), cB + hstep, voffB); PG8_STAGE(PG8_SA(0, 1), cA + hstep, voffA);
        if (wr == 1) PG8_BAR;
        PG8_WAIT_V(4); PG8_BAR;
        PG8_STAGE(PG8_SB(1, 0), cB + kstep, voffB); PG8_STAGE(PG8_SA(1, 0), cA + kstep, voffA); PG8_STAGE(PG8_SB(1, 1), cB + hstep + kstep, voffB);
        PG8_WAIT_V(6); PG8_BAR;
    }
    for (;;) {
        const bool has_next = S.next(ui + 1, nxt);
        const char* nA = has_next ? (const char*)g.A + (size_t)nxt.pm * tstep : cA; const char* nB = has_next ? (const char*)g.Bt + (size_t)nxt.pn * tstep : cB;
        for (int t = 0; t < nt; t += 2) {
            const bool last = (t == nt - 2);
            const char* a1 = cA + (size_t)(t + 1) * kstep;
            const char* a2 = last ? nA : cA + (size_t)(t + 2) * kstep; const char* b2 = last ? nB : cB + (size_t)(t + 2) * kstep;
            const char* a3 = a2 + kstep; const char* b3 = b2 + kstep;
            if (last && has_next) S.a_ready(nxt);
            if constexpr (SP2) {
            PG8_LDB(B0, 0, 0); PG8_LDB(B1, 0, 1); PG8_SCHED; PG8_LDA(At, 0, 0); PG8_STAGE(PG8_SA(1, 1), a1 + hstep, voffA);
            PG8_WAIT_V(8); PG8_WAIT_L(0); PG8_BAR; PG8_MMA(0, 0, At, B0); PG8_MMA(0, 1, At, B1); PG8_BAR; PG8_SCHED;
            PG8_LDA(At, 0, 1); PG8_STAGE(PG8_SB(0, 0), b2, voffB); PG8_STAGE(PG8_SB(0, 1), b2 + hstep, voffB); PG8_STAGE(PG8_SA(0, 0), a2, voffA);
            PG8_WAIT_V(8); PG8_WAIT_L(0); PG8_BAR; PG8_MMA(1, 0, At, B0); PG8_MMA(1, 1, At, B1); PG8_BAR; PG8_SCHED;
            PG8_LDB(B0, 1, 0); PG8_LDB(B1, 1, 1); PG8_SCHED; PG8_LDA(At, 1, 0); PG8_STAGE(PG8_SA(0, 1), a2 + hstep, voffA);
            PG8_WAIT_V(8); PG8_WAIT_L(0); PG8_BAR; PG8_MMA(0, 0, At, B0); PG8_MMA(0, 1, At, B1); PG8_BAR; PG8_SCHED;
            PG8_LDA(At, 1, 1); PG8_STAGE(PG8_SB(1, 0), b3, voffB); PG8_STAGE(PG8_SB(1, 1), b3 + hstep, voffB); PG8_STAGE(PG8_SA(1, 0), a3, voffA);
            PG8_WAIT_V(8); PG8_WAIT_L(0); PG8_BAR; PG8_MMA(1, 0, At, B0); PG8_MMA(1, 1, At, B1); PG8_BAR; PG8_SCHED;
            } else {
            PG8_LDB(B0, 0, 0); PG8_SCHED; PG8_LDA(At, 0, 0); PG8_STAGE(PG8_SA(1, 1), a1 + hstep, voffA);
            PG8_WAIT_L(8); PG8_BAR; PG8_WAIT_L(0); PG8_MMA(0, 0, At, B0); PG8_BAR; PG8_SCHED;
            PG8_LDB(B1, 0, 1); PG8_STAGE(PG8_SB(0, 0), b2, voffB);
            PG8_BAR; PG8_WAIT_L(0); PG8_MMA(0, 1, At, B1); PG8_BAR;
            PG8_LDA(At, 0, 1); PG8_STAGE(PG8_SA(0, 0), a2, voffA);
            PG8_BAR; PG8_WAIT_L(0); PG8_MMA(1, 0, At, B0); PG8_BAR; PG8_SCHED;
            PG8_STAGE(PG8_SB(0, 1), b2 + hstep, voffB);
            PG8_WAIT_V(6); PG8_BAR; PG8_MMA(1, 1, At, B1); PG8_BAR;
            PG8_LDB(B0, 1, 0); PG8_SCHED; PG8_LDA(At, 1, 0); PG8_STAGE(PG8_SA(0, 1), a2 + hstep, voffA);
            PG8_WAIT_L(8); PG8_BAR; PG8_WAIT_L(0); PG8_MMA(0, 0, At, B0); PG8_BAR; PG8_SCHED;
            PG8_LDB(B1, 1, 1); PG8_STAGE(PG8_SB(1, 0), b3, voffB);
            PG8_BAR; PG8_WAIT_L(0); PG8_MMA(0, 1, At, B1); PG8_BAR;
            PG8_LDA(At, 1, 1); PG8_STAGE(PG8_SA(1, 0), a3, voffA);
            PG8_BAR; PG8_WAIT_L(0); PG8_MMA(1, 0, At, B0); PG8_BAR; PG8_SCHED;
            PG8_STAGE(PG8_SB(1, 1), b3 + hstep, voffB);
            PG8_WAIT_V(6); PG8_BAR; PG8_MMA(1, 1, At, B1); PG8_BAR;
            }
        }
        if constexpr (ALIGN_EPI) { if (wr == 0) PG8_BAR; }
        if constexpr (!Epi::AFTER_DRAIN) { E(acc, cur, wr, wc, fr, fq); S.done(cur); }
        if (!has_next) break;
#pragma unroll
        for (int a = 0; a < 2; ++a)
#pragma unroll
            for (int b = 0; b < 2; ++b)
#pragma unroll
                for (int m = 0; m < 4; ++m)
#pragma unroll
                    for (int n = 0; n < 2; ++n) acc[a][b][m][n] = (f32x4){0.f, 0.f, 0.f, 0.f};
        cur = nxt; cA = nA; cB = nB; ++ui;
        if constexpr (ALIGN_EPI) { if (wr == 1) PG8_BAR; }
    }
    PG8_WAIT_V(0);
    if constexpr (!ALIGN_EPI) { if (wr == 0) PG8_BAR; }
    PG8_BAR;
    if constexpr (Epi::AFTER_DRAIN) { E.fused(acc, cur, wr, wc, fr, fq, lds, wid, lane); S.done(cur); }
#undef PG8_SA
#undef PG8_SB
#undef PG8_STAGE
#undef PG8_LDA
#undef PG8_LDB
#undef PG8_MMA
#undef PG8_WAIT_V
#undef PG8_WAIT_L
#undef PG8_BAR
#undef PG8_SCHED
}
}
constexpr int NWAVES = 8;
constexpr int DM = 1024, NB = 16, SEQ = 4096, MP = NB * SEQ  , SB = 128, ST = 8, MS = SB * ST  , MTOT = MP + MS  ;
constexpr int NIN = 3840;
constexpr int HA = 8, HD = 64, DA = 512, HB = 4, DKB = 64, DVB = 128, DBB = 512, RANK = 16, WIN = 2048, PAST = 8192;
constexpr float EPS = 1e-6f;
constexpr float LOG2E = 1.4426950408889634f;
constexpr float QSCALE = 0.125f * LOG2E;
constexpr size_t OUT_YP = 0, OUT_YS = OUT_YP + (size_t)MP * DM, OUT_KWIN = OUT_YS + (size_t)MS * DM, OUT_VWIN = OUT_KWIN + (size_t)NB * WIN * DA,
                 OUT_SP = OUT_VWIN + (size_t)NB * WIN * DA, OUT_KNEW = OUT_SP + (size_t)NB * HB * DKB * DVB, OUT_VNEW = OUT_KNEW + (size_t)MS * DA,
                 OUT_SS = OUT_VNEW + (size_t)MS * DA, OUT_END = OUT_SS + (size_t)SB * HB * DKB * DVB;
constexpr size_t MiB = 1u << 20;
constexpr size_t WS_CTL = 0, CTL_ZERO_BYTES = 1 * MiB;
constexpr size_t WS_WIN = 2 * MiB;
constexpr size_t WS_WOUT = 10 * MiB;
constexpr size_t WS_ROPE = 12 * MiB;
constexpr size_t WS_RSTD = 14 * MiB;
constexpr size_t WS_SCAL = 15 * MiB;
constexpr size_t WS_XB = 16 * MiB;
constexpr size_t WS_Q = 160 * MiB, WS_K = 228 * MiB, WS_V = 296 * MiB;
constexpr size_t WS_QB = 364 * MiB, WS_KB = 398 * MiB;
constexpr size_t WS_VB = 432 * MiB;
constexpr size_t WS_LOGA = 500 * MiB;
constexpr size_t WS_GA = 568 * MiB, WS_GB = 636 * MiB;
constexpr size_t WS_OPART = 704 * MiB;
constexpr size_t WS_LPART = 900 * MiB;
constexpr size_t WS_MIX = 908 * MiB;
constexpr size_t WS_END = 1040 * MiB;
constexpr size_t OPART_STRIDE = (size_t)MP * DA;
constexpr size_t LPART_STRIDE = (size_t)MP * HA;
constexpr int CW_TMO = 0, CW_CODE = 1;
constexpr int CW_TICKET = 64;
constexpr int CW_TICKET_A = 320;
constexpr int CW_TICKET_G = 384;
constexpr int CW_TICKET2 = 128;
constexpr int CW_P0A = 192;
constexpr int CW_BAR = 4096;
constexpr int RING_OFF = 0, RING_BYTES = 131072;
constexpr int LDSCTL_OFF = RING_BYTES, MISC_OFF = LDSCTL_OFF + 320;
constexpr int OSTAGE_OFF = LDSCTL_OFF + 512, LDS_BYTES = OSTAGE_OFF + 16384;
#define GAS __attribute__((address_space(1)))
#define LAS __attribute__((address_space(3)))
typedef unsigned short bf16;
typedef unsigned v4u __attribute__((ext_vector_type(4)));
typedef unsigned v2u __attribute__((ext_vector_type(2)));
typedef float f32x4 __attribute__((ext_vector_type(4)));
typedef float f32x2 __attribute__((ext_vector_type(2)));
typedef float f32x16 __attribute__((ext_vector_type(16)));
typedef short bf16x8 __attribute__((ext_vector_type(8)));
typedef short s16x4 __attribute__((ext_vector_type(4)));
typedef GAS unsigned gu32;
#define RLX_AGENT __ATOMIC_RELAXED, __HIP_MEMORY_SCOPE_AGENT
#define LDS_WAIT() asm volatile("s_waitcnt lgkmcnt(0)" ::: "memory")
#define NTLD(p) __builtin_nontemporal_load(p)
#define VM_WAIT() asm volatile("s_waitcnt vmcnt(0)" ::: "memory")
#define LBAR() do { asm volatile("s_waitcnt lgkmcnt(0)" ::: "memory"); __builtin_amdgcn_s_barrier(); asm volatile("" ::: "memory"); } while (0)
__device__ __forceinline__ unsigned f2bf(float f) { unsigned u = __builtin_bit_cast(unsigned, f); return (u + 0x7fffu + ((u >> 16) & 1u)) >> 16; }
__device__ __forceinline__ unsigned pk2(float lo, float hi) { typedef float f2 __attribute__((ext_vector_type(2))); typedef __bf16 b2 __attribute__((ext_vector_type(2))); f2 v = {lo, hi}; b2 b = __builtin_convertvector(v, b2); return __builtin_bit_cast(unsigned, b); }
__device__ __forceinline__ float bflo(unsigned u) { return __builtin_bit_cast(float, u << 16); }
__device__ __forceinline__ float bfhi(unsigned u) { return __builtin_bit_cast(float, u & 0xffff0000u); }
__device__ __forceinline__ v4u pack8(const f32x4 a, const f32x4 b) { v4u w; w.x = pk2(a[0], a[1]); w.y = pk2(a[2], a[3]); w.z = pk2(b[0], b[1]); w.w = pk2(b[2], b[3]); return w; }
__device__ __forceinline__ float wave_sum(float v) {
#pragma unroll
    for (int o = 1; o < 64; o <<= 1) v += __shfl_xor(v, o);
    return v;
}
__device__ __forceinline__ float wave_max(float v) {
#pragma unroll
    for (int o = 1; o < 64; o <<= 1) v = fmaxf(v, __shfl_xor(v, o));
    return v;
}
__device__ __forceinline__ float fast_exp2(float x) { return __builtin_amdgcn_exp2f(x); }
__device__ __forceinline__ float fast_exp(float x) { return __builtin_amdgcn_exp2f(x * LOG2E); }
__device__ __forceinline__ float silu_f(float x) { return x * __builtin_amdgcn_rcpf(1.0f + fast_exp(-x)); }
struct TileT {
    LAS unsigned char* T; int w0, w1, wa0, wa1, ro, rr, p;
    __device__ __forceinline__ void init(LAS unsigned char* stg, int wid, int fr, int fq) {
        T = stg + wid * 2048; const int lane = fr + 16 * fq; rr = lane >> 3; p = lane & 7; const int k = fr & 7;
        w0 = fr * 128 + ((fq ^ k) << 4); w1 = fr * 128 + (((4 + fq) ^ k) << 4);
        wa0 = fr * 128 + (((2 * fq) ^ k) << 4); wa1 = fr * 128 + (((2 * fq + 1) ^ k) << 4);
        ro = rr * 128 + ((p ^ rr) << 4);
    }
    __device__ __forceinline__ void bf(const v4u x0, const v4u x1, v4u& a, v4u& b) const {
        *(LAS v4u*)(T + w0) = x0; *(LAS v4u*)(T + w1) = x1; a = *(const LAS v4u*)(T + ro); b = *(const LAS v4u*)(T + ro + 1024); }
    __device__ __forceinline__ void f4(const f32x4 x0, const f32x4 x1, f32x4& a, f32x4& b) const {
        *(LAS f32x4*)(T + wa0) = x0; *(LAS f32x4*)(T + wa1) = x1; a = *(const LAS f32x4*)(T + ro); b = *(const LAS f32x4*)(T + ro + 1024); }
};
struct EpiIn {
    static constexpr bool PERM = true, AFTER_DRAIN = false;
    const float* rstd; const float* rope; const float* nwb  ; const float* bgate;
    unsigned char* ws; float* out; LAS unsigned char* stg;
    __device__ __forceinline__ void operator()(const f32x4 (&acc)[2][2][4][2], const pg8::Unit& u, int wr, int wc, int fr, int fq) const {
        asm volatile("" : "+v"(fr), "+v"(fq));
        const int pn = u.pn, pm = u.pm;
        const bool sample = pm >= (MP / 256);
        TileT tt; tt.init(stg, wr * 4 + wc, fr, fq);
        float rs8[2][4];
#pragma unroll
        for (int ai = 0; ai < 2; ++ai)
#pragma unroll
            for (int m = 0; m < 4; ++m) rs8[ai][m] = rstd[256 * pm + 128 * ai + 64 * wr + 16 * m + fr];
        if (pn < 4) {
            const int head = 4 * (pn & 1) + wc; const bool isq = pn < 2;
            const float* nw = nwb + (isq ? 0 : 64);
            f32x4 w[2][2];
#pragma unroll
            for (int bj = 0; bj < 2; ++bj)
#pragma unroll
                for (int n = 0; n < 2; ++n) w[bj][n] = *(const f32x4*)(nw + 32 * bj + 8 * fq + 4 * n);
            bf16* dst = (bf16*)(ws + (isq ? WS_Q : WS_K));
            const bool wout = !isq && (sample || (pm & 15) >= 8);
            const int rbase = 64 * wr + fr;
            f32x4 tn[4];
            { const int ri0 = sample ? (SEQ + (rbase & 7)) : (256 * (pm & 15) + rbase); const f32x4* tp0 = (const f32x4*)(rope + (size_t)ri0 * 64 + 16 * fq);
#pragma unroll
              for (int q = 0; q < 4; ++q) tn[q] = tp0[q]; }
#pragma unroll
            for (int ai = 0; ai < 2; ++ai)
#pragma unroll
                for (int m = 0; m < 4; ++m) {
                    const int rit = 128 * ai + 16 * m + rbase;
                    f32x4 tc[4];
#pragma unroll
                    for (int q = 0; q < 4; ++q) tc[q] = tn[q];
                    if (ai * 4 + m < 7) {
                        const int ritn = rit + (m == 3 ? 80 : 16); const int rin = sample ? (SEQ + (ritn & 7)) : (256 * (pm & 15) + ritn);
                        const f32x4* tpn = (const f32x4*)(rope + (size_t)rin * 64 + 16 * fq);
#pragma unroll
                        for (int q = 0; q < 4; ++q) tn[q] = tpn[q];
                    }
                    const float rs = rs8[ai][m];
                    f32x4 x[2][2]; float ss = 0.f;
#pragma unroll
                    for (int bj = 0; bj < 2; ++bj)
#pragma unroll
                        for (int n = 0; n < 2; ++n) { x[bj][n] = acc[ai][bj][m][n] * rs; const f32x4 t = x[bj][n]; ss += (t[0] * t[0] + t[1] * t[1]) + (t[2] * t[2] + t[3] * t[3]); }
                    ss += __shfl_xor(ss, 16); ss += __shfl_xor(ss, 32);
                    const float rn = __builtin_amdgcn_rsqf(ss * (1.0f / 64.0f) + EPS);
                    f32x4 o1[2], o2[2];
#pragma unroll
                    for (int n = 0; n < 2; ++n) {
                        const f32x4 ta = tc[2 * n], tb = tc[2 * n + 1];
                        const f32x4 y1 = x[0][n] * rn * w[0][n], y2 = x[1][n] * rn * w[1][n];
                        const f32x4 c = {ta[0], ta[2], tb[0], tb[2]}, s = {ta[1], ta[3], tb[1], tb[3]};
                        o1[n] = y1 * c - y2 * s; o2[n] = y2 * c + y1 * s;
                    }
                    const int rowa = 256 * pm + 128 * ai + 64 * wr + 16 * m + tt.rr;
                    { v4u a, b; if (isq) tt.bf(pack8(o1[0] * QSCALE, o1[1] * QSCALE), pack8(o2[0] * QSCALE, o2[1] * QSCALE), a, b); else tt.bf(pack8(o1[0], o1[1]), pack8(o2[0], o2[1]), a, b);
                      bf16* d = dst + (size_t)rowa * DA + head * 64 + 8 * tt.p; *(v4u*)d = a; *(v4u*)(d + 8 * DA) = b; }
                    if (wout) {
                        const int rl = 128 * ai + 64 * wr + 16 * m + tt.rr;
                        float* op = sample ? out + OUT_KNEW + (size_t)(rowa - MP) * DA : out + OUT_KWIN + ((size_t)(pm >> 4) * WIN + (256 * (pm & 15) + rl - (SEQ - WIN))) * DA;
                        op += head * 64 + 4 * tt.p;
                        f32x4 a, b; tt.f4(o1[0], o1[1], a, b); *(f32x4*)op = a; *(f32x4*)(op + 8 * DA) = b;
                        tt.f4(o2[0], o2[1], a, b); *(f32x4*)(op + 32) = a; *(f32x4*)(op + 32 + 8 * DA) = b;
                    }
                }
        } else if (pn < 6) {
            const int head = 4 * (pn & 1) + wc;
            const bool wout = sample || (pm & 15) >= 8;
#pragma unroll
            for (int ai = 0; ai < 2; ++ai)
#pragma unroll
                for (int m = 0; m < 4; ++m) {
                    const int rl = 128 * ai + 64 * wr + 16 * m + tt.rr, rowa = 256 * pm + rl;
                    const float rs = rs8[ai][m];
                    const f32x4 a0 = acc[ai][0][m][0] * rs, a1 = acc[ai][0][m][1] * rs, b0 = acc[ai][1][m][0] * rs, b1 = acc[ai][1][m][1] * rs;
                    { v4u a, b; tt.bf(pack8(a0, a1), pack8(b0, b1), a, b);
                      bf16* d = (bf16*)(ws + WS_V) + (size_t)rowa * DA + head * 64 + 8 * tt.p; *(v4u*)d = a; *(v4u*)(d + 8 * DA) = b; }
                    if (wout) {
                        float* op = sample ? out + OUT_VNEW + (size_t)(rowa - MP) * DA : out + OUT_VWIN + ((size_t)(pm >> 4) * WIN + (256 * (pm & 15) + rl - (SEQ - WIN))) * DA;
                        op += head * 64 + 4 * tt.p;
                        f32x4 a, b; tt.f4(a0, a1, a, b); *(f32x4*)op = a; *(f32x4*)(op + 8 * DA) = b;
                        tt.f4(b0, b1, a, b); *(f32x4*)(op + 32) = a; *(f32x4*)(op + 32 + 8 * DA) = b;
                    }
                }
        } else if (pn < 8) {
            bf16* dst = (bf16*)(ws + (pn == 6 ? WS_QB : WS_KB)); const float sc = pn == 6 ? 0.125f : 1.0f;
#pragma unroll
            for (int ai = 0; ai < 2; ++ai)
#pragma unroll
                for (int m = 0; m < 4; ++m) {
                    const int rowa = 256 * pm + 128 * ai + 64 * wr + 16 * m + tt.rr;
                    const float rs = rs8[ai][m] * sc;
                    v4u a, b; tt.bf(pack8(acc[ai][0][m][0] * rs, acc[ai][0][m][1] * rs), pack8(acc[ai][1][m][0] * rs, acc[ai][1][m][1] * rs), a, b);
                    bf16* d = dst + (size_t)rowa * 256 + wc * 64 + 8 * tt.p; *(v4u*)d = a; *(v4u*)(d + 8 * 256) = b;
                }
        } else if (pn < 14) {
            bf16* dst = (bf16*)(ws + (pn < 10 ? WS_VB : (pn < 12 ? WS_GA : WS_GB))); const bool act = pn >= 10;
            const int cb = 256 * (pn & 1) + 64 * wc + 8 * tt.p;
#pragma unroll
            for (int ai = 0; ai < 2; ++ai)
#pragma unroll
                for (int m = 0; m < 4; ++m) {
                    const int rowa = 256 * pm + 128 * ai + 64 * wr + 16 * m + tt.rr;
                    const float rs = rs8[ai][m];
                    v4u pk[2];
#pragma unroll
                    for (int bj = 0; bj < 2; ++bj) {
                        f32x4 a = acc[ai][bj][m][0] * rs, b = acc[ai][bj][m][1] * rs;
                        if (act) {
#pragma unroll
                            for (int j = 0; j < 4; ++j) { a[j] = silu_f(a[j]); b[j] = silu_f(b[j]); }
                        }
                        pk[bj] = pack8(a, b);
                    }
                    v4u a, b; tt.bf(pk[0], pk[1], a, b);
                    bf16* d = dst + (size_t)rowa * 512 + cb; *(v4u*)d = a; *(v4u*)(d + 8 * 512) = b;
                }
        } else {
            f32x4 bg[2][2];
#pragma unroll
            for (int bj = 0; bj < 2; ++bj)
#pragma unroll
                for (int n = 0; n < 2; ++n) bg[bj][n] = *(const f32x4*)(bgate + 64 * wc + 32 * bj + 8 * fq + 4 * n);
#pragma unroll
            for (int ai = 0; ai < 2; ++ai)
#pragma unroll
                for (int m = 0; m < 4; ++m) {
                    const int rowa = 256 * pm + 128 * ai + 64 * wr + 16 * m + tt.rr;
                    const float rs = rs8[ai][m];
                    v4u pk[2];
#pragma unroll
                    for (int bj = 0; bj < 2; ++bj) {
                        f32x4 r2[2];
#pragma unroll
                        for (int n = 0; n < 2; ++n) {
                            const f32x4 z = acc[ai][bj][m][n] * rs + bg[bj][n];
#pragma unroll
                            for (int j = 0; j < 4; ++j) { const float az = fabsf(z[j]); r2[n][j] = (fminf(z[j], 0.f) - __logf(1.0f + fast_exp(-az))) * (1.0f / 16.0f); }
                        }
                        pk[bj] = pack8(r2[0], r2[1]);
                    }
                    v4u a, b; tt.bf(pk[0], pk[1], a, b);
                    bf16* d = (bf16*)(ws + WS_LOGA) + (size_t)rowa * 256 + 64 * wc + 8 * tt.p; *(v4u*)d = a; *(v4u*)(d + 8 * 256) = b;
                }
        }
    }
};
struct EpiOut {
    static constexpr bool PERM = false, AFTER_DRAIN = false;
    const bf16* xbf; float* out; LAS unsigned char* stg;
    __device__ __forceinline__ void operator()(const f32x4 (&acc)[2][2][4][2], const pg8::Unit& u, int wr, int wc, int fr, int fq) const {
        asm volatile("" : "+v"(fr), "+v"(fq));
        const int pm = u.pm; const bool sample = pm >= (MP / 256);
        const bf16* xb = xbf + (size_t)pm * 256 * DM;
        float* ob = sample ? out + OUT_YS + (size_t)(pm - MP / 256) * 256 * DM : out + OUT_YP + (size_t)pm * 256 * DM;
        LAS unsigned char* T = stg + (wr * 4 + wc) * 2048;
        const int lane = fr + 16 * fq, rr = lane >> 3, p = lane & 7;
        const int woff0 = fr * 128 + ((fq ^ (fr & 7)) << 4), woff1 = fr * 128 + (((4 + fq) ^ (fr & 7)) << 4);
        const int roff = rr * 128 + ((p ^ rr) << 4);
        const int cb = 256 * u.pn + 32 * wc + 4 * p;
#pragma unroll
        for (int ai = 0; ai < 2; ++ai) {
            v4u xv[4][2][2];
#pragma unroll
            for (int m = 0; m < 4; ++m) {
                const size_t ro = (size_t)(128 * ai + 64 * wr + 16 * m + rr) * DM + (cb & ~7);
#pragma unroll
                for (int bj = 0; bj < 2; ++bj) { xv[m][bj][0] = NTLD((const v4u*)(xb + ro + 128 * bj)); xv[m][bj][1] = NTLD((const v4u*)(xb + ro + 8 * DM + 128 * bj)); }
            }
#pragma unroll
            for (int m = 0; m < 4; ++m) {
                const size_t ro = (size_t)(128 * ai + 64 * wr + 16 * m + rr) * DM + cb;
#pragma unroll
                for (int bj = 0; bj < 2; ++bj) {
                    *(LAS f32x4*)(T + woff0) = acc[ai][bj][m][0]; *(LAS f32x4*)(T + woff1) = acc[ai][bj][m][1];
                    const f32x4 a0 = *(const LAS f32x4*)(T + roff), a1 = *(const LAS f32x4*)(T + roff + 1024);
                    const v4u t0 = xv[m][bj][0], t1 = xv[m][bj][1];
                    const unsigned u0 = (p & 1) ? t0.z : t0.x, u1 = (p & 1) ? t0.w : t0.y, u2 = (p & 1) ? t1.z : t1.x, u3 = (p & 1) ? t1.w : t1.y;
                    *(f32x4*)(ob + ro + 128 * bj) = (f32x4){bflo(u0), bfhi(u0), bflo(u1), bfhi(u1)} + a0; *(f32x4*)(ob + ro + 8 * DM + 128 * bj) = (f32x4){bflo(u2), bfhi(u2), bflo(u3), bfhi(u3)} + a1;
                }
            }
        }
    }
};
#define XB_TMO      128
#define XB_XCNT(j)  (256  + 64 * (j))
#define XB_XSUB(j)  (1280 + 64 * (j))
#define XB_XGEN(j)  (2304 + 64 * (j))
#define XB_TOP      3328
#define XB_TOPGEN   3392
#define XCD_BAR_WORDS 3456
#define XB_SPIN_CAP (1u << 18)

__device__ __forceinline__ unsigned xb_ld(unsigned* p)              { return __hip_atomic_load(p, __ATOMIC_RELAXED, __HIP_MEMORY_SCOPE_AGENT); }
__device__ __forceinline__ unsigned xb_add(unsigned* p, unsigned v) { return __hip_atomic_fetch_add(p, v, __ATOMIC_RELAXED, __HIP_MEMORY_SCOPE_AGENT); }
__device__ __forceinline__ unsigned xb_xcc_id() { return (unsigned)__builtin_amdgcn_s_getreg((3 << 11) | 20) & 0xFu; }
#define XB_SPIN(cond, bar) do { unsigned _sp = 0; while (cond) { __builtin_amdgcn_s_sleep(1); \
    if ((++_sp & 255u) == 0u) { if (xb_ld(&(bar)[XB_TMO])) break; if (_sp > XB_SPIN_CAP) { atomicAdd(&(bar)[XB_TMO], 1u); break; } } } } while (0)

struct XcdBarrier {
    unsigned* bar; unsigned x;
    volatile LAS unsigned* st;
};

__device__ __forceinline__ XcdBarrier xcd_barrier_post(unsigned* bar, volatile LAS unsigned* st) {
    XcdBarrier b; b.bar = bar; b.x = xb_xcc_id(); b.st = st;
    if (threadIdx.x == 0) (void)xb_add(&bar[XB_XCNT(b.x)], 1u);
    return b;
}
__device__ __forceinline__ void xcd_barrier_complete(unsigned* bar, unsigned x, unsigned& nloc, unsigned& nx) {
    const unsigned G = gridDim.x * gridDim.y * gridDim.z;
    unsigned sum, cnt, mine, sp = 0u;
    for (;;) {
        sum = 0u; cnt = 0u; mine = 0u;
#pragma unroll
        for (unsigned j = 0; j < 16; ++j) { const unsigned c = xb_ld(&bar[XB_XCNT(j)]); sum += c; cnt += (c > 0u) ? 1u : 0u; mine = (j == x) ? c : mine; }
        if (sum == G) break;
        __builtin_amdgcn_s_sleep(1);
        if ((++sp & 255u) == 0u) { if (xb_ld(&bar[XB_TMO])) break; if (sp > XB_SPIN_CAP) { atomicAdd(&bar[XB_TMO], 1u); break; } }
    }
    nloc = mine > 0u ? mine : 1u; nx = cnt > 0u ? cnt : 1u;
}

__device__ __forceinline__ void xcd_barrier(const XcdBarrier& b) {
    asm volatile("s_waitcnt vmcnt(0)" ::: "memory");
    __syncthreads();
    if (threadIdx.x == 0) {
        unsigned* bar = b.bar;
        __builtin_amdgcn_s_waitcnt(0);
        unsigned nloc = b.st[0], nx = b.st[1];
        if (nloc == 0u) { xcd_barrier_complete(bar, b.x, nloc, nx); b.st[0] = nloc; b.st[1] = nx; }
        const unsigned old = xb_add(&bar[XB_XSUB(b.x)], 1u);
        const unsigned gen = old / nloc;
        if (old + 1u == (gen + 1u) * nloc) {
            __builtin_amdgcn_fence(__ATOMIC_RELEASE, "agent");
            asm volatile("s_waitcnt vmcnt(0)" ::: "memory");
            const unsigned og = xb_add(&bar[XB_TOP], 1u);
            const unsigned tg = og / nx;
            if (og + 1u == (tg + 1u) * nx) xb_add(&bar[XB_TOPGEN], 1u);
            else XB_SPIN(xb_ld(&bar[XB_TOPGEN]) == tg, bar);
            __builtin_amdgcn_fence(__ATOMIC_ACQUIRE, "agent");
            xb_add(&bar[XB_XGEN(b.x)], 1u);
            asm volatile("s_waitcnt vmcnt(0)" ::: "memory");
        } else {
            XB_SPIN(xb_ld(&bar[XB_XGEN(b.x)]) == gen, bar);
            __builtin_amdgcn_fence(__ATOMIC_ACQUIRE, "agent");
            asm volatile("s_waitcnt vmcnt(0)" ::: "memory");
        }
    }
    __syncthreads();
}
struct Args { const float* in[13]; float* out; unsigned char* ws; int ph_lo, ph_hi, item_mask, pad; };
struct Frame {
    LAS unsigned char* lds; volatile LAS unsigned* MISC; gu32* ctl;
    int tid, lane, wave, G, item_mask;
    float* out; unsigned char* ws;
};
__device__ __forceinline__ const Args* args_ptr() {
#if defined(__HIP_DEVICE_COMPILE__)
    const void* p = (const void*)__builtin_amdgcn_kernarg_segment_ptr(); asm volatile("" : "+s"(p)); return (const Args*)p;
#else
    return nullptr;
#endif
}
#define INP(k) (args_ptr()->in[k])
enum { I_XP = 0, I_XS, I_CK, I_CV, I_SG, I_NORMW, I_WIN, I_WGU, I_BGATE, I_QNW, I_KNW, I_GNW, I_WOUT };
#define WSP(T, off) ((T*)(F.ws + (off)))

__device__ __forceinline__ void p0_transpose_item(const float* W, int ldw, int srccol0, const float* kscale, bf16* WT, int K, int dstrow0, LAS float* scr, int k0, int lane) {
    float wv[32], sv[32];
#pragma unroll
    for (int i = 0; i < 32; ++i) { const int kk = 2 * i + (lane >> 5); wv[i] = W[(size_t)(k0 + kk) * ldw + srccol0 + (lane & 31)]; }
#pragma unroll
    for (int i = 0; i < 32; ++i) { const int kk = 2 * i + (lane >> 5); sv[i] = kscale ? kscale[k0 + kk] : 1.0f; }
#pragma unroll
    for (int i = 0; i < 32; ++i) { const int kk = 2 * i + (lane >> 5); scr[kk * 33 + (lane & 31)] = wv[i] * sv[i]; }
    LDS_WAIT(); asm volatile("" ::: "memory");
    const int c = lane & 7;
#pragma unroll
    for (int j = 0; j < 4; ++j) { const int n = (lane >> 3) + 8 * j; const LAS float* s = scr + (8 * c) * 33 + n;
        v4u o; o.x = pk2(s[0 * 33], s[1 * 33]); o.y = pk2(s[2 * 33], s[3 * 33]); o.z = pk2(s[4 * 33], s[5 * 33]); o.w = pk2(s[6 * 33], s[7 * 33]);
        *(v4u*)(WT + (size_t)(dstrow0 + n) * K + k0 + 8 * c) = o; }
    LDS_WAIT(); asm volatile("" ::: "memory");
}
__device__ __forceinline__ int in_src_col(int n0) {
    const int pn = n0 >> 8, within = n0 & 255, bj = within >> 7, wc = (within & 127) >> 5;
    if (pn < 6) return 512 * (pn >> 1) + 64 * (4 * (pn & 1) + wc) + 32 * bj;
    if (pn == 6) return 1536 + 64 * wc + 32 * bj;
    if (pn == 7) return 1792 + 64 * wc + 32 * bj;
    if (pn < 10) return 2048 + 256 * (pn - 8) + 64 * wc + 32 * bj;
    if (pn < 12) return 2576 + 256 * (pn - 10) + 64 * wc + 32 * bj;
    return 3088 + 256 * (pn - 12) + 64 * wc + 32 * bj;
}
__device__ __forceinline__ void p0_convert_row(Frame& F, const float* xp_, const float* xs_, int m) {
    const float* xrow = m < MP ? xp_ + (size_t)m * DM : xs_ + (size_t)(m - MP) * DM;
    const f32x4* xr = (const f32x4*)xrow + F.lane;
    f32x4 v[4]; float s = 0.f;
#pragma unroll
    for (int j = 0; j < 4; ++j) { v[j] = NTLD(xr + 64 * j); s += (v[j][0] * v[j][0] + v[j][1] * v[j][1]) + (v[j][2] * v[j][2] + v[j][3] * v[j][3]); }
    s = wave_sum(s);
    if (F.lane == 0) WSP(float, WS_RSTD)[m] = 1.0f / sqrtf(s * (1.0f / DM) + EPS);
    v2u* o8 = (v2u*)(WSP(bf16, WS_XB) + (size_t)m * DM) + F.lane;
#pragma unroll
    for (int j = 0; j < 4; ++j) { v2u o; o.x = pk2(v[j][0], v[j][1]); o.y = pk2(v[j][2], v[j][3]); o8[64 * j] = o; }
}
__device__ __forceinline__ void p0_convert_row2(Frame& F, const float* xp_, int m0, int m1) {
    const f32x4* xa = (const f32x4*)(xp_ + (size_t)m0 * DM) + F.lane; const f32x4* xb = (const f32x4*)(xp_ + (size_t)m1 * DM) + F.lane;
    f32x4 va[4], vb[4]; float sa = 0.f, sb = 0.f;
#pragma unroll
    for (int j = 0; j < 4; ++j) { va[j] = NTLD(xa + 64 * j); vb[j] = NTLD(xb + 64 * j); }
#pragma unroll
    for (int j = 0; j < 4; ++j) { sa += (va[j][0] * va[j][0] + va[j][1] * va[j][1]) + (va[j][2] * va[j][2] + va[j][3] * va[j][3]); sb += (vb[j][0] * vb[j][0] + vb[j][1] * vb[j][1]) + (vb[j][2] * vb[j][2] + vb[j][3] * vb[j][3]); }
    sa = wave_sum(sa); sb = wave_sum(sb);
    if (F.lane == 0) { WSP(float, WS_RSTD)[m0] = 1.0f / sqrtf(sa * (1.0f / DM) + EPS); WSP(float, WS_RSTD)[m1] = 1.0f / sqrtf(sb * (1.0f / DM) + EPS); }
    v2u* oa = (v2u*)(WSP(bf16, WS_XB) + (size_t)m0 * DM) + F.lane; v2u* ob = (v2u*)(WSP(bf16, WS_XB) + (size_t)m1 * DM) + F.lane;
#pragma unroll
    for (int j = 0; j < 4; ++j) { v2u o; o.x = pk2(va[j][0], va[j][1]); o.y = pk2(va[j][2], va[j][3]); oa[64 * j] = o; v2u p; p.x = pk2(vb[j][0], vb[j][1]); p.y = pk2(vb[j][2], vb[j][3]); ob[64 * j] = p; }
}
__device__ __forceinline__ void p0_prologue(Frame& F) {
    const Args* A_ = args_ptr();
    const float *xp_ = A_->in[I_XP], *xs_ = A_->in[I_XS], *normw_ = A_->in[I_NORMW], *win_ = A_->in[I_WIN], *wgu_ = A_->in[I_WGU], *qnw_ = A_->in[I_QNW], *knw_ = A_->in[I_KNW], *wout_ = A_->in[I_WOUT];
    LAS float* scr = (LAS float*)(F.lds + RING_OFF + F.wave * 16384);
    bf16* WinT = WSP(bf16, WS_WIN); bf16* WoutT = WSP(bf16, WS_WOUT);
    const int bx = (int)blockIdx.x;
    constexpr int G_TR = 144, G_GW = 32, G_RO = 16;
    if (bx < G_TR) {
        constexpr int I_IN = 112 * 16, I_OUT = 32 * 16;
        for (int it = bx * NWAVES + F.wave; it < I_IN + I_OUT; it += G_TR * NWAVES) {
            if (it < I_IN) { const int ng = it >> 4, kb = it & 15; p0_transpose_item(win_, 3600, in_src_col(32 * ng), normw_, WinT, DM, 32 * ng, scr, 64 * kb, F.lane); }
            else { const int r = it - I_IN, ng = r >> 4, kb = r & 15; p0_transpose_item(wout_, DM, 32 * ng, nullptr, WoutT, DM, 32 * ng, scr, 64 * kb, F.lane); }
        }
    } else if (bx < G_TR + G_GW) {
        for (int it = (bx - G_TR) * (NWAVES * 64) + F.tid; it < 256 * 128; it += G_GW * NWAVES * 64) {
            const int c = it & 255, k8 = it >> 8; float r[8];
            const int lc = 64 * ((c >> 5) & 3) + 32 * (c >> 7) + (c & 31);
#pragma unroll
            for (int kk = 0; kk < 8; ++kk) { const int k = 8 * k8 + kk; const float* wr_ = win_ + (size_t)k * 3600 + 2560; float s = 0.f;
#pragma unroll
                for (int q = 0; q < RANK; ++q) s += wr_[q] * wgu_[q * 256 + lc];
                r[kk] = s * normw_[k]; }
            v4u o; o.x = pk2(r[0], r[1]); o.y = pk2(r[2], r[3]); o.z = pk2(r[4], r[5]); o.w = pk2(r[6], r[7]);
            *(v4u*)(WinT + (size_t)(3584 + c) * DM + 8 * k8) = o;
        }
    } else if (bx < G_TR + G_GW + G_RO) {
        float* rope = WSP(float, WS_ROPE);
        for (int it = (bx - G_TR - G_GW) * (NWAVES * 64) + F.tid; it < (SEQ + ST) * 32; it += G_RO * NWAVES * 64) {
            const int ri = it >> 5, d = it & 31; const float pos = (float)(ri < SEQ ? ri : PAST + (ri - SEQ));
            const float invf = exp2f(-(float)d * (13.287712379549449f / 32.0f));
            float s, c; sincosf(pos * invf, &s, &c);
            rope[2 * it] = c; rope[2 * it + 1] = s;
        }
        if (bx == G_TR + G_GW && F.wave == 0) {
            const float mq = wave_max(fabsf(qnw_[F.lane])), mk = wave_max(fabsf(knw_[F.lane]));
            if (F.lane == 0) WSP(float, WS_SCAL)[0] = 8.0f * LOG2E * mq * mk;
            WSP(float, WS_SCAL)[64 + F.lane] = qnw_[F.lane]; WSP(float, WS_SCAL)[128 + F.lane] = knw_[F.lane];
        }
    } else {
        const int ng = F.G - (G_TR + G_GW + G_RO);
        for (int m = MP + (bx - (G_TR + G_GW + G_RO)) * NWAVES + F.wave; m < MTOT; m += ng * NWAVES) p0_convert_row(F, xp_, xs_, m);
    }
}
__device__ __forceinline__ void p0b_convert(Frame& F) {
    const Args* A_ = args_ptr(); const float *xp_ = A_->in[I_XP], *xs_ = A_->in[I_XS];
    if (F.tid == 0) F.MISC[5] = __hip_atomic_fetch_add(F.ctl + CW_TICKET2, 1u, RLX_AGENT);
    LBAR(); int t = __builtin_amdgcn_readfirstlane((int)F.MISC[5]); LBAR();
    while (t < MP / 64) {
        unsigned nt = 0u;
        if (F.tid == 0) nt = __hip_atomic_fetch_add(F.ctl + CW_TICKET2, 1u, RLX_AGENT);
#pragma unroll 1
        for (int i = 0; i < 8; i += 2) p0_convert_row2(F, xp_, 64 * t + 8 * i + F.wave, 64 * t + 8 * (i + 1) + F.wave);
        if (F.tid == 0) F.MISC[5] = nt;
        LBAR(); t = __builtin_amdgcn_readfirstlane((int)F.MISC[5]); LBAR();
    }
}
typedef short v4i16_t __attribute__((ext_vector_type(4)));
__device__ __forceinline__ s16x4 tr16(const LAS unsigned char* p) { return __builtin_bit_cast(s16x4, __builtin_amdgcn_ds_read_tr16_b64_v4i16((LAS v4i16_t*)p)); }
__device__ __forceinline__ bf16x8 cat8(s16x4 lo, s16x4 hi) { return (bf16x8){lo[0], lo[1], lo[2], lo[3], hi[0], hi[1], hi[2], hi[3]}; }
__device__ __forceinline__ bf16x8 pk8(f32x4 a, f32x4 b) { return __builtin_bit_cast(bf16x8, pack8(a, b)); }
#define MFMA16(a, b, c) __builtin_amdgcn_mfma_f32_16x16x32_bf16((a), (b), (c), 0, 0, 0)
#define MFMA32(a, b, c) __builtin_amdgcn_mfma_f32_32x32x16_bf16((a), (b), (c), 0, 0, 0)

constexpr int G_QT = 0, G_RP = 144, G_KT = 9216, G_V = 18432, G_VP = 288, G_P = 36864, G_O = 46080, G_OP = 528, G_TOT = 79872, G_D = 83968;
__device__ __forceinline__ void gla_prompt_item(Frame& F, int b, int h) {
    int tid = F.tid; asm volatile("" : "+v"(tid));
    const int lane = tid & 63, w = __builtin_amdgcn_readfirstlane(tid >> 6), g = lane >> 4, i16 = lane & 15;
    LAS unsigned char* L = F.lds + RING_OFF;
    const bf16* QBp = WSP(bf16, WS_QB); const bf16* KBp = WSP(bf16, WS_KB); const bf16* VBp = WSP(bf16, WS_VB); const bf16* GBp = WSP(bf16, WS_GB);
    const bf16* LOGA = WSP(bf16, WS_LOGA); bf16* MIX = WSP(bf16, WS_MIX);
#ifdef PROBE_VARIANTS
    const int var = F.item_mask >> 8;
    if (var) MIX = WSP(bf16, (size_t)1100 * MiB);
#else
    constexpr int var = 0;
#endif
    const size_t tokb = (size_t)b * SEQ;
    const int kp = tid & 31, seg = tid >> 5;
    const int et = tid >> 3, evc = tid & 7;
    f32x4 gw4[4];
#pragma unroll
    for (int q = 0; q < 4; ++q) gw4[q] = *(const f32x4*)(INP(I_GNW) + 16 * evc + 4 * q);
    f32x4 sacc[4];
#pragma unroll
    for (int kb = 0; kb < 4; ++kb) sacc[kb] = (f32x4){0.f, 0.f, 0.f, 0.f};
    f32x2 lg[4]; unsigned qv[4], kv[4]; v4u vv[2]; v4u gg[2]; v4u outp[2] = {};
#define GLA_LOAD(n) do { const size_t t0_ = tokb + 64 * (size_t)(n); \
        _Pragma("unroll") for (int i = 0; i < 4; ++i) { const size_t tk = t0_ + 4 * seg + i; { const unsigned lr_ = *(const unsigned*)(LOGA + tk * 256 + h * 64 + 2 * kp); lg[i] = (f32x2){bflo(lr_), bfhi(lr_)}; } \
            qv[i] = *(const unsigned*)(QBp + tk * 256 + h * 64 + 2 * kp); kv[i] = *(const unsigned*)(KBp + tk * 256 + h * 64 + 2 * kp); } \
        _Pragma("unroll") for (int i = 0; i < 2; ++i) { const int p_ = tid + 512 * i, row_ = p_ >> 4, c_ = p_ & 15; vv[i] = *(const v4u*)(VBp + (t0_ + row_) * 512 + h * 128 + 8 * c_); } } while (0)
    GLA_LOAD(0);
    for (int n = 0; n < SEQ / 64; ++n) {
        const size_t t0 = tokb + 64 * (size_t)n;
        f32x2 cs[4]; cs[0] = lg[0];
#pragma unroll
        for (int i = 1; i < 4; ++i) cs[i] = cs[i - 1] + lg[i];
        *(LAS f32x2*)(L + G_TOT + (seg * 64 + 2 * kp) * 4) = cs[3];
#pragma unroll
        for (int i = 0; i < 2; ++i) { const int p_ = tid + 512 * i, row_ = p_ >> 4, c_ = p_ & 15; *(LAS v4u*)(L + G_V + row_ * G_VP + c_ * 16) = vv[i]; }
        LBAR();
        if (n > 0) {
#pragma unroll
            for (int i = 0; i < 2; ++i) *(v4u*)(MIX + (t0 - 64 + et) * DM + DA + h * 128 + 16 * evc + 8 * i) = outp[i];
        }
        f32x2 pre = {0.f, 0.f}, tot = {0.f, 0.f};
#pragma unroll
        for (int s = 0; s < 16; ++s) { const f32x2 v = *(const LAS f32x2*)(L + G_TOT + (s * 64 + 2 * kp) * 4); if (s < seg) pre += v; tot += v; }
#pragma unroll
        for (int i = 0; i < 4; ++i) {
            f32x2 bb = pre + cs[i]; bb.x = fmaxf(bb.x, -80.f); bb.y = fmaxf(bb.y, -80.f);
            const float ep0 = fast_exp(bb.x), ep1 = fast_exp(bb.y), em0 = fast_exp(-bb.x), em1 = fast_exp(-bb.y);
            const int t = 4 * seg + i;
            *(LAS unsigned*)(L + G_QT + t * G_RP + kp * 4) = pk2(bflo(qv[i]) * ep0, bfhi(qv[i]) * ep1);
            *(LAS unsigned*)(L + G_KT + t * G_RP + kp * 4) = pk2(bflo(kv[i]) * em0, bfhi(kv[i]) * em1);
        }
        if (seg == 0) { f32x2 dd; dd.x = fast_exp(fmaxf(tot.x, -80.f)); dd.y = fast_exp(fmaxf(tot.y, -80.f)); *(LAS f32x2*)(L + G_D + 2 * kp * 4) = dd; }
#pragma unroll
        for (int i = 0; i < 2; ++i) gg[i] = *(const v4u*)(GBp + (t0 + et) * 512 + h * 128 + 16 * evc + 8 * i);
        if (n + 1 < SEQ / 64 && var != 2) GLA_LOAD(n + 1);
        LBAR();
        if (var != 3) {
            const int tb = w >> 1;
#pragma unroll
            for (int q2 = 0; q2 < 2; ++q2) {
                const int sb = 2 * (w & 1) + q2;
                f32x4 c4 = {0.f, 0.f, 0.f, 0.f};
                if (sb <= tb) {
#pragma unroll
                    for (int sp = 0; sp < 2; ++sp) {
                        const bf16x8 a = *(const LAS bf16x8*)(L + G_KT + (16 * sb + i16) * G_RP + (32 * sp + 8 * g) * 2);
                        const bf16x8 bq = *(const LAS bf16x8*)(L + G_QT + (16 * tb + i16) * G_RP + (32 * sp + 8 * g) * 2);
                        c4 = MFMA16(a, bq, c4);
                    }
                }
                const int t = 16 * tb + i16, s0 = 16 * sb + 4 * g;
#pragma unroll
                for (int r = 0; r < 4; ++r) if (s0 + r > t) c4[r] = 0.f;
                v2u pk; pk.x = pk2(c4[0], c4[1]); pk.y = pk2(c4[2], c4[3]);
                *(LAS v2u*)(L + G_P + t * G_RP + s0 * 2) = pk;
            }
        }
        LBAR();
        if (var != 1) {
            bf16x8 vf[2];
#pragma unroll
            for (int sp = 0; sp < 2; ++sp) { const LAS unsigned char* vp = L + G_V + (32 * sp + 8 * g + (i16 >> 2)) * G_VP + (16 * w + 4 * (i16 & 3)) * 2; vf[sp] = cat8(tr16(vp), tr16(vp + 4 * G_VP)); }
            bf16x8 pa[4][2], qa[4][2];
#pragma unroll
            for (int tb = 0; tb < 4; ++tb)
#pragma unroll
                for (int sp = 0; sp < 2; ++sp) {
                    if (!(sp == 1 && tb < 2)) pa[tb][sp] = *(const LAS bf16x8*)(L + G_P + (16 * tb + i16) * G_RP + (32 * sp + 8 * g) * 2);
                    const v2u a0 = *(const LAS v2u*)(L + G_QT + (16 * tb + i16) * G_RP + (32 * sp + 4 * g) * 2);
                    const v2u a1 = *(const LAS v2u*)(L + G_QT + (16 * tb + i16) * G_RP + (32 * sp + 16 + 4 * g) * 2);
                    v4u aa; aa.x = a0.x; aa.y = a0.y; aa.z = a1.x; aa.w = a1.y; qa[tb][sp] = __builtin_bit_cast(bf16x8, aa);
                }
            bf16x8 bs[2];
#pragma unroll
            for (int sp = 0; sp < 2; ++sp) bs[sp] = pk8(sacc[2 * sp], sacc[2 * sp + 1]);
            __builtin_amdgcn_sched_barrier(0);
            f32x4 oacc[4];
#pragma unroll
            for (int tb = 0; tb < 4; ++tb) oacc[tb] = MFMA16(qa[tb][0], bs[0], ((f32x4){0.f, 0.f, 0.f, 0.f}));
#pragma unroll
            for (int tb = 0; tb < 4; ++tb) oacc[tb] = MFMA16(qa[tb][1], bs[1], oacc[tb]);
#pragma unroll
            for (int tb = 0; tb < 4; ++tb) oacc[tb] = MFMA16(pa[tb][0], vf[0], oacc[tb]);
#pragma unroll
            for (int tb = 2; tb < 4; ++tb) oacc[tb] = MFMA16(pa[tb][1], vf[1], oacc[tb]);
            __builtin_amdgcn_sched_barrier(0);
            bf16x8 ka[4][2]; f32x4 dv[4];
#pragma unroll
            for (int kb = 0; kb < 4; ++kb) {
#pragma unroll
                for (int sp = 0; sp < 2; ++sp) { const LAS unsigned char* kq = L + G_KT + (32 * sp + 8 * g + (i16 >> 2)) * G_RP + (16 * kb + 4 * (i16 & 3)) * 2; ka[kb][sp] = cat8(tr16(kq), tr16(kq + 4 * G_RP)); }
                dv[kb] = *(const LAS f32x4*)(L + G_D + (16 * kb + 4 * g) * 4);
            }
#pragma unroll
            for (int tb = 0; tb < 4; ++tb)
#pragma unroll
                for (int r = 0; r < 4; ++r) *(LAS float*)(L + G_O + (16 * tb + 4 * g + r) * G_OP + (16 * w + i16) * 4) = oacc[tb][r];
            __builtin_amdgcn_sched_barrier(0);
#pragma unroll
            for (int kb = 0; kb < 4; ++kb) sacc[kb] = MFMA16(ka[kb][0], vf[0], sacc[kb]);
#pragma unroll
            for (int kb = 0; kb < 4; ++kb) sacc[kb] = MFMA16(ka[kb][1], vf[1], sacc[kb]);
#pragma unroll
            for (int kb = 0; kb < 4; ++kb) sacc[kb] = sacc[kb] * dv[kb];
        }
        LBAR();
        {
            f32x4 o4[4]; float ss = 0.f;
#pragma unroll
            for (int q = 0; q < 4; ++q) { o4[q] = *(const LAS f32x4*)(L + G_O + et * G_OP + (16 * evc + 4 * q) * 4); ss += (o4[q][0] * o4[q][0] + o4[q][1] * o4[q][1]) + (o4[q][2] * o4[q][2] + o4[q][3] * o4[q][3]); }
            ss += __shfl_xor(ss, 1); ss += __shfl_xor(ss, 2); ss += __shfl_xor(ss, 4);
            const float rn = __builtin_amdgcn_rsqf(ss * (1.0f / 128.0f) + EPS);
#pragma unroll
            for (int i = 0; i < 2; ++i) {
                const f32x4 ga = {bflo(gg[i].x), bfhi(gg[i].x), bflo(gg[i].y), bfhi(gg[i].y)}, gb = {bflo(gg[i].z), bfhi(gg[i].z), bflo(gg[i].w), bfhi(gg[i].w)};
                const f32x4 ra = o4[2 * i] * rn * gw4[2 * i] * ga, rb = o4[2 * i + 1] * rn * gw4[2 * i + 1] * gb;
                outp[i] = pack8(ra, rb);
            }
        }
    }
#pragma unroll
    for (int i = 0; i < 2; ++i) *(v4u*)(MIX + (tokb + 64 * (size_t)(SEQ / 64 - 1) + et) * DM + DA + h * 128 + 16 * evc + 8 * i) = outp[i];
#undef GLA_LOAD
    float* so = (var ? WSP(float, (size_t)1300 * MiB) : F.out + OUT_SP) + ((size_t)(b * HB + h) * DKB) * DVB;
#pragma unroll
    for (int kb = 0; kb < 4; ++kb)
#pragma unroll
        for (int r = 0; r < 4; ++r) so[(size_t)(16 * kb + 4 * g + r) * DVB + 16 * w + i16] = sacc[kb][r];
    LBAR();
}

__device__ __forceinline__ void gla_sample_item(Frame& F, int b, int h) {
    int tid = F.tid; asm volatile("" : "+v"(tid));
    const int lane = tid & 63, w = __builtin_amdgcn_readfirstlane(tid >> 6);
    LAS float* LA = (LAS float*)(F.lds + RING_OFF);
    LAS float* LK = LA + 512; LAS float* LQ = LK + 512;
    LAS float* LV = LQ + 512;
    LAS float* LO = LV + 1024;
    const bf16* QBp = WSP(bf16, WS_QB); const bf16* KBp = WSP(bf16, WS_KB); const bf16* VBp = WSP(bf16, WS_VB); const bf16* GBp = WSP(bf16, WS_GB);
    const bf16* LOGA = WSP(bf16, WS_LOGA); bf16* MIX = WSP(bf16, WS_MIX);
    const size_t row0 = (size_t)MP + 8 * b;
    { const int t = tid >> 6, k = tid & 63; const size_t r = row0 + t;
      LA[tid] = fast_exp(bflo((unsigned)LOGA[r * 256 + h * 64 + k]));
      LK[tid] = bflo((unsigned)KBp[r * 256 + h * 64 + k]); LQ[tid] = bflo((unsigned)QBp[r * 256 + h * 64 + k]);
#pragma unroll
      for (int i = 0; i < 2; ++i) { const int e = tid + 512 * i, tt = e >> 7, v = e & 127; LV[e] = bflo((unsigned)VBp[(row0 + tt) * 512 + h * 128 + v]); } }
    const int v = tid & 127, kq = tid >> 7;
    const float* sin_ = INP(I_SG) + ((size_t)(b * HB + h) * DKB + 16 * kq) * DVB + v;
    float S[16];
#pragma unroll
    for (int i = 0; i < 16; ++i) S[i] = sin_[(size_t)i * DVB];
    LBAR();
#pragma unroll
    for (int t = 0; t < 8; ++t) {
        const float vt = LV[t * 128 + v]; float po = 0.f;
#pragma unroll
        for (int i = 0; i < 16; ++i) { const int k = 16 * kq + i; S[i] = LA[t * 64 + k] * S[i] + LK[t * 64 + k] * vt; po += LQ[t * 64 + k] * S[i]; }
        LO[(t * 4 + kq) * 128 + v] = po;
    }
    float* sout = F.out + OUT_SS + ((size_t)(b * HB + h) * DKB + 16 * kq) * DVB + v;
#pragma unroll
    for (int i = 0; i < 16; ++i) sout[(size_t)i * DVB] = S[i];
    LBAR();
    { const int t = w, v2 = 2 * lane;
      float o0 = 0.f, o1 = 0.f;
#pragma unroll
      for (int q = 0; q < 4; ++q) { const f32x2 p = *(const LAS f32x2*)(LO + (t * 4 + q) * 128 + v2); o0 += p.x; o1 += p.y; }
      const float ss = wave_sum(o0 * o0 + o1 * o1);
      const float rn = __builtin_amdgcn_rsqf(ss * (1.0f / 128.0f) + EPS);
      const unsigned gt = *(const unsigned*)(GBp + (row0 + t) * 512 + h * 128 + v2);
      const f32x2 gw = *(const f32x2*)(INP(I_GNW) + v2);
      *(unsigned*)(MIX + (row0 + t) * DM + DA + h * 128 + v2) = pk2(o0 * rn * gw.x * bflo(gt), o1 * rn * gw.y * bfhi(gt)); }
    LBAR();
}

__device__ __forceinline__ void attn_sample_item(Frame& F, int b, int h) {
    int tid = F.tid; asm volatile("" : "+v"(tid));
    const int lane = tid & 63, w = __builtin_amdgcn_readfirstlane(tid >> 6), g4 = lane >> 4, c = lane & 15;
    const bf16* Qp = WSP(bf16, WS_Q); const bf16* GAp = WSP(bf16, WS_GA); bf16* MIX = WSP(bf16, WS_MIX);
    const float mref = WSP(const float, WS_SCAL)[0];
    const size_t row0 = (size_t)MP + 8 * b;
    LAS float* PART = (LAS float*)(F.lds + RING_OFF);
#define AS_LDQ(tt) ({ const v2u r_ = *(const v2u*)(Qp + (row0 + (tt)) * DA + h * 64 + 4 * c); (f32x4){bflo(r_.x), bfhi(r_.x), bflo(r_.y), bfhi(r_.y)}; })
    const float* cK = INP(I_CK) + ((size_t)b * WIN * HA + h) * HD + 4 * c; const float* cV = INP(I_CV) + ((size_t)b * WIN * HA + h) * HD + 4 * c;
    const float* nK = F.out + OUT_KNEW + ((size_t)b * ST * HA + h) * HD + 4 * c; const float* nV = F.out + OUT_VNEW + ((size_t)b * ST * HA + h) * HD + 4 * c;
#define AS_ROW(idx_, kv_, vv_) do { const int ix_ = (idx_); const bool fr_ = ix_ >= WIN;        \
        const float* kp_ = fr_ ? nK + (size_t)(ix_ - WIN) * (HA * HD) : cK + (size_t)ix_ * (HA * HD); const float* vp_ = fr_ ? nV + (size_t)(ix_ - WIN) * (HA * HD) : cV + (size_t)ix_ * (HA * HD); \
        kv_ = NTLD((const f32x4*)kp_); vv_ = NTLD((const f32x4*)vp_); } while (0)
#define AS_ROR(x_, n_) __builtin_bit_cast(float, __builtin_amdgcn_update_dpp(0, __builtin_bit_cast(int, (x_)), 0x120 + (n_), 0xf, 0xf, true))
#define AS_DOT(kv_, q_) ({ float d_ = ((kv_)[0] * (q_)[0] + (kv_)[1] * (q_)[1]) + ((kv_)[2] * (q_)[2] + (kv_)[3] * (q_)[3]); \
        d_ += AS_ROR(d_, 8); d_ += AS_ROR(d_, 4); d_ += AS_ROR(d_, 2); d_ += AS_ROR(d_, 1); d_; })
#define AS_PUT(slot_, o_, l_) do { f32x4 oo_ = (o_); float ll_ = (l_); \
        _Pragma("unroll") for (int j_ = 0; j_ < 4; ++j_) { oo_[j_] += __shfl_xor(oo_[j_], 16); oo_[j_] += __shfl_xor(oo_[j_], 32); } \
        ll_ += __shfl_xor(ll_, 16); ll_ += __shfl_xor(ll_, 32); \
        if (g4 == 0) { *(LAS f32x4*)(PART + (slot_) * 68 + 4 * c) = oo_; if (c == 0) PART[(slot_) * 68 + 64] = ll_; } } while (0)
    {
        const f32x4 qown = AS_LDQ(w);
        f32x4 o16 = {0.f, 0.f, 0.f, 0.f}; float l16 = 0.f;
#pragma unroll 1
        for (int it0 = 0; it0 < 32; it0 += 4) {
            f32x4 kv[4], vv[4];
#pragma unroll
            for (int u = 0; u < 4; ++u) AS_ROW(WIN + w - 16 * (4 * (it0 + u) + g4), kv[u], vv[u]);
#pragma unroll
            for (int u = 0; u < 4; ++u) { const float p = fast_exp2(AS_DOT(kv[u], qown) - mref); l16 += p; o16 += vv[u] * p; }
        }
        { f32x4 kv, vv; AS_ROW(WIN + w - 16 * 128, kv, vv); const float d = AS_DOT(kv, qown); const float p = g4 == 0 ? fast_exp2(d - mref) : 0.f; l16 += p; o16 += vv * p; }
        AS_PUT(w, o16, l16);
    }
    if (w < 4) {
        const f32x4 q4a = AS_LDQ(w), q4b = AS_LDQ(w + 4);
        f32x4 o4a = {0.f, 0.f, 0.f, 0.f}, o4b = {0.f, 0.f, 0.f, 0.f}; float l4a = 0.f, l4b = 0.f;
#pragma unroll 1
        for (int it0 = 0; it0 < 32; it0 += 4) {
            f32x4 kv[4], vv[4];
#pragma unroll
            for (int u = 0; u < 4; ++u) AS_ROW(WIN + w + 4 - 4 * (4 * (it0 + u) + g4), kv[u], vv[u]);
#pragma unroll
            for (int u = 0; u < 4; ++u) {
                const int m = 4 * (it0 + u) + g4;
                const float da = AS_DOT(kv[u], q4a), db = AS_DOT(kv[u], q4b);
                const float pa = m >= 1 ? fast_exp2(da - mref) : 0.f, pb = fast_exp2(db - mref);
                l4a += pa; o4a += vv[u] * pa; l4b += pb; o4b += vv[u] * pb;
            }
        }
        { const int m = 128 + (g4 & 1); f32x4 kv, vv; AS_ROW(WIN + w + 4 - 4 * m, kv, vv);
          const float da = AS_DOT(kv, q4a), db = AS_DOT(kv, q4b);
          const float pa = g4 < 2 ? fast_exp2(da - mref) : 0.f, pb = g4 == 0 ? fast_exp2(db - mref) : 0.f;
          l4a += pa; o4a += vv * pa; l4b += pb; o4b += vv * pb; }
        AS_PUT(8 + w, o4a, l4a); AS_PUT(12 + w, o4b, l4b);
    } else {
        f32x4 q[8];
#pragma unroll
        for (int tt = 0; tt < 8; ++tt) q[tt] = AS_LDQ(tt);
        f32x4 o1[8]; float l1[8];
#pragma unroll
        for (int tt = 0; tt < 8; ++tt) { o1[tt] = (f32x4){0.f, 0.f, 0.f, 0.f}; l1[tt] = 0.f; }
        const int i0 = 34 * (w - 4);
#pragma unroll 1
        for (int it0 = 0; it0 < 8; it0 += 4) {
            f32x4 kv[4], vv[4];
#pragma unroll
            for (int u = 0; u < 4; ++u) AS_ROW(WIN - 128 + i0 + 4 * (it0 + u) + g4, kv[u], vv[u]);
#pragma unroll
            for (int u = 0; u < 4; ++u) {
                const int i = i0 + 4 * (it0 + u) + g4;
#pragma unroll
                for (int tt = 0; tt < 8; ++tt) { const float d = AS_DOT(kv[u], q[tt]); const float p = (i >= tt && i <= tt + 128) ? fast_exp2(d - mref) : 0.f; l1[tt] += p; o1[tt] += vv[u] * p; }
            }
        }
        { const int i = i0 + 32 + (g4 & 1); f32x4 kv, vv; AS_ROW(WIN - 128 + i, kv, vv);
#pragma unroll
          for (int tt = 0; tt < 8; ++tt) { const float d = AS_DOT(kv, q[tt]); const float p = (g4 < 2 && i >= tt && i <= tt + 128) ? fast_exp2(d - mref) : 0.f; l1[tt] += p; o1[tt] += vv * p; } }
#pragma unroll
        for (int tt = 0; tt < 8; ++tt) AS_PUT(16 + 8 * (w - 4) + tt, o1[tt], l1[tt]);
    }
#undef AS_LDQ
#undef AS_ROW
#undef AS_DOT
#undef AS_ROR
#undef AS_PUT
    LBAR();
    if (g4 == 0) {
        const int s4 = w < 4 ? 8 + w : 12 + (w - 4);
        f32x4 o = *(const LAS f32x4*)(PART + w * 68 + 4 * c) + *(const LAS f32x4*)(PART + s4 * 68 + 4 * c);
        float l = PART[w * 68 + 64] + PART[s4 * 68 + 64];
#pragma unroll
        for (int j = 0; j < 4; ++j) { o += *(const LAS f32x4*)(PART + (16 + 8 * j + w) * 68 + 4 * c); l += PART[(16 + 8 * j + w) * 68 + 64]; }
        const size_t row = row0 + w; const float rl = 1.0f / l;
        const v2u gr = *(const v2u*)(GAp + row * DA + h * 64 + 4 * c);
        v2u w_; w_.x = pk2(o[0] * rl * bflo(gr.x), o[1] * rl * bfhi(gr.x)); w_.y = pk2(o[2] * rl * bflo(gr.y), o[3] * rl * bfhi(gr.y));
        *(v2u*)(MIX + row * DM + h * 64 + 4 * c) = w_;
    }
    LBAR();
}
constexpr int N_GLAP = NB * HB, N_ATTS = SB * HA, N_GLAS = SB * HB, N_ATTP = 3 * NB * HA * 4;
constexpr int T_ATTP = 0, T_ATTS = N_ATTP, T_TOTAL = N_ATTP;
constexpr int SLOT_K = 16384, RING_V = 65536;
struct AItem { int b, h, g, x, nsteps; };
struct AStep { int b, h, g, D, r, kb, compute, valid; };
__device__ __forceinline__ AItem aitem_decode(int idx, int var = 0) {
    AItem a; const int bh = idx / 12, sub = idx - 12 * bh; a.g = sub >> 2;
#ifdef PROBE_VARIANTS
    if (var >= 1 && var <= 3) a.g = var - 1;
#endif
    a.b = bh >> 3; a.h = bh & 7; a.x = sub & 3; a.nsteps = 8 + ((a.g == 2 && a.x > 0) ? 1 : 0); return a;
}
__device__ __forceinline__ AStep astep(const AItem& it, int k) {
    AStep s; s.b = it.b; s.h = it.h; s.g = it.g; s.valid = 1; s.compute = 1;
    if (it.g == 0) { s.D = 16; s.r = 4 * it.x + (k >> 1); s.kb = k & 1; }
    else if (it.g == 1) { s.D = 4; s.r = it.x; s.kb = k; }
    else { const int pre = it.x > 0 ? 1 : 0; s.D = 1; s.r = 0; s.kb = 8 * it.x - pre + k; s.compute = (pre && k == 0) ? 0 : 1; }
    return s;
}
__device__ __forceinline__ AStep astep2(const AItem& cur, const AItem& nxt, bool has_nxt, int k_rel) {
    if (k_rel < cur.nsteps) return astep(cur, k_rel);
    if (has_nxt) return astep(nxt, k_rel - cur.nsteps);
    AStep s = astep(cur, 0); s.valid = 0; s.compute = 0; return s;
}
__device__ __forceinline__ void glds16(const void* gsrc, unsigned lds_dst) { unsigned keep;
    asm volatile("s_mov_b32 %0, m0\n\ts_mov_b32 m0, %2\n\ts_nop 0\n\tglobal_load_lds_dwordx4 %1, off\n\ts_mov_b32 m0, %0" : "=&s"(keep) : "v"(gsrc), "s"(lds_dst) : "memory"); }
__device__ __forceinline__ void att_dma_slot(Frame& F, const AStep& st, int slot, int w, int lane) {
    const bf16* Kp = WSP(bf16, WS_K); const bf16* Vp = WSP(bf16, WS_V);
    LAS unsigned char* sb = F.lds + RING_OFF + slot * SLOT_K;
    const size_t rowb = (size_t)st.b * SEQ + st.r; const int m0 = 128 * st.kb;
#pragma unroll
    for (int e = 0; e < 2; ++e) {
        const int key = 16 * w + 8 * e + (lane >> 3), p = lane & 7; const size_t row = rowb + (size_t)(m0 + key) * st.D;
        glds16(Kp + row * DA + st.h * 64 + (p ^ ((key >> 1) & 7)) * 8, (unsigned)__builtin_amdgcn_readfirstlane((int)(unsigned)(__UINTPTR_TYPE__)(sb + (16 * w + 8 * e) * 128)));
        glds16(Vp + row * DA + st.h * 64 + (p ^ (2 * ((key >> 1) & 3))) * 8, (unsigned)__builtin_amdgcn_readfirstlane((int)(unsigned)(__UINTPTR_TYPE__)(sb + RING_V + (16 * w + 8 * e) * 128)));
    }
}
__device__ __forceinline__ int crow(int r, int hi) { return (r & 3) + 8 * (r >> 2) + 4 * hi; }
__device__ __forceinline__ void q_load2(v4u (&q)[2], const bf16* p) {
    asm volatile("global_load_dwordx4 %0, %2, off\n\tglobal_load_dwordx4 %1, %2, off offset:64" : "=&v"(q[0]), "=&v"(q[1]) : "v"(p) : "memory");
}
#define WAITV_CASE(n) case n: asm volatile("s_waitcnt vmcnt(" #n ")" : "+v"(dep) :: "memory"); break;
__device__ __forceinline__ void wait_vm(int n, unsigned& dep) {
    switch (n) { WAITV_CASE(2) WAITV_CASE(3) WAITV_CASE(4) WAITV_CASE(5) WAITV_CASE(6) WAITV_CASE(7) WAITV_CASE(8) WAITV_CASE(9) WAITV_CASE(10) WAITV_CASE(11) default: asm volatile("s_waitcnt vmcnt(0)" : "+v"(dep) :: "memory"); }
}
template <bool FIRST, bool WRAP>
__device__ __forceinline__ void att_compute(const LAS unsigned char* ring, int prev, const bf16x8 (&qf)[2], float mref, int qw, int lane, f32x4 (&o)[4], f32x4& lacc, int pv = 0) {
    const int ql = lane & 15, g = lane >> 4, i16 = lane & 15;
    const int ksw = (ql >> 1) & 7;
    const int koff0 = ql * 128 + ((g ^ ksw) * 16), koff1 = ql * 128 + (((4 + g) ^ ksw) * 16);
    const int vrowl = 4 * g + (i16 >> 2), vsw = 2 * ((vrowl >> 1) & 3), vpc = (i16 & 3) >> 1;
    const int voff = vrowl * 128 + (i16 & 1) * 8;
#define ATT_ROWB(kw) (WRAP ? ((((kw) < 128) ? 3 * 128 + (kw) : (kw) - 128) * 128) : ((prev * 128 + (kw)) * 128))
    const LAS unsigned char* kb0 = ring + koff0; const LAS unsigned char* kb1 = ring + koff1; const LAS unsigned char* vb = ring + RING_V + voff;
    const LAS unsigned char* vbd[4];
#pragma unroll
    for (int dt = 0; dt < 4; ++dt) vbd[dt] = vb + (((2 * dt + vpc) ^ vsw) * 16);
    const int wb = WRAP ? 0 : (prev * 128 + 16 * qw) * 128;
    f32x4 st[9];
#pragma unroll
    for (int t = 0; t < 9; ++t) {
        const int rb = WRAP ? ATT_ROWB(16 * (qw + t)) : wb + t * 2048;
        const bf16x8 a0 = *(const LAS bf16x8*)(kb0 + rb), a1 = *(const LAS bf16x8*)(kb1 + rb);
        f32x4 c = {-mref, -mref, -mref, -mref};
        c = MFMA16(a0, qf[0], c); st[t] = MFMA16(a1, qf[1], c);
    }
    s16x4 va[2][4][2];
#define ATT_VLOAD(u, buf) do { const int r0_ = WRAP ? ATT_ROWB(16 * (qw + 2 * (u))) : wb + 2 * (u) * 2048; \
        const int r1_ = ((u) < 4) ? (WRAP ? ATT_ROWB(16 * (qw + 2 * (u) + 1)) : wb + (2 * (u) + 1) * 2048) : r0_; \
        _Pragma("unroll") for (int dt = 0; dt < 4; ++dt) { va[buf][dt][0] = tr16(vbd[dt] + r0_); va[buf][dt][1] = tr16(vbd[dt] + r1_); } } while (0)
    ATT_VLOAD(0, 0);
#pragma unroll
    for (int t = 0; t < 9; ++t) {
#pragma unroll
        for (int r = 0; r < 4; ++r) {
            float p = fast_exp2(st[t][r]);
            if (t == 0) { if (4 * g + r < ql) p = 0.f; }
            if (t == 8) { if (4 * g + r > ql) p = 0.f; }
            if (FIRST) { if (qw + t < 8) p = 0.f; }
            st[t][r] = p;
        }
    }
    const v4u one4 = {0x3F803F80u, 0x3F803F80u, 0x3F803F80u, 0x3F803F80u}; const bf16x8 ones = __builtin_bit_cast(bf16x8, one4);
#pragma unroll
    for (int u = 0; u < 5; ++u) {
        if (u < 4) ATT_VLOAD(u + 1, (u + 1) & 1);
        __builtin_amdgcn_sched_barrier(0);
        const f32x4 z = {0.f, 0.f, 0.f, 0.f};
        const bf16x8 pb = pk8(st[2 * u], (u < 4) ? st[2 * u + 1] : z);
#pragma unroll
        for (int dt = 0; dt < 4; ++dt) o[dt] = MFMA16(cat8(va[u & 1][dt][0], va[u & 1][dt][1]), pb, o[dt]);
        lacc = MFMA16(ones, pb, lacc);
        __builtin_amdgcn_sched_barrier(0);
    }
#undef ATT_VLOAD
#undef ATT_ROWB
}
__device__ __forceinline__ void att_q_dma(Frame& F, const AStep& st, int w, int lane) {
    const bf16* Qp = WSP(bf16, WS_Q);
    LAS unsigned char* T = F.lds + OSTAGE_OFF + w * 2048;
#pragma unroll
    for (int e = 0; e < 2; ++e) {
        const int rr = lane >> 3, q = 16 * w + 8 * e + rr, p = (lane & 7) ^ rr;
        const size_t row = (size_t)st.b * SEQ + (size_t)(128 * st.kb + q) * st.D + st.r;
        glds16(Qp + row * DA + st.h * 64 + p * 8, (unsigned)__builtin_amdgcn_readfirstlane((int)(unsigned)(__UINTPTR_TYPE__)(T + e * 1024)));
    }
}
__device__ __forceinline__ int attn_prompt_loop(Frame& F, int t) {
    int tid_ = F.tid; asm volatile("" : "+v"(tid_));
    const int lane = tid_ & 63, w = __builtin_amdgcn_readfirstlane(tid_ >> 6), ql = lane & 15, g4 = lane >> 4;
    bf16* OP = WSP(bf16, WS_OPART); float* LP = WSP(float, WS_LPART);
    const float mref = WSP(const float, WS_SCAL)[0];
    const LAS unsigned char* L = F.lds + RING_OFF;
    LAS unsigned char* stg = F.lds + OSTAGE_OFF + w * 2048;
    const int qoff0 = ql * 128 + ((g4 ^ (ql & 7)) << 4), qoff1 = ql * 128 + (((4 + g4) ^ (ql & 7)) << 4);
    { LAS v4u* z = (LAS v4u*)(F.lds + RING_OFF + RING_V + 3 * SLOT_K); z[tid_] = (v4u){0u, 0u, 0u, 0u}; z[tid_ + 512] = (v4u){0u, 0u, 0u, 0u}; }
    const int avar = F.item_mask >> 8;
    AItem cur = aitem_decode(t - T_ATTP, avar), nxt = cur; bool has_nxt = false; int tret = T_TOTAL;
    int k = 0, sc = 0;
    AStep st = astep(cur, 0);
    att_q_dma(F, st, w, lane);
    att_dma_slot(F, st, 0, w, lane);
    const AStep s1 = astep(cur, 1);
    att_dma_slot(F, s1, 1, w, lane);
    unsigned dep0 = 0u;
    wait_vm(8, dep0);
    v4u qn[2]; qn[0] = *(const LAS v4u*)(stg + qoff0); qn[1] = *(const LAS v4u*)(stg + qoff1);
    LDS_WAIT();
    att_q_dma(F, s1, w, lane);
    bool d0 = true, d1 = true, first = true, h2 = false;
    unsigned tkt = 0u;
    v4u ost[2] = {}; float lst = 0.f; bf16* ostp = nullptr; float* lstp = nullptr; bool have_st = false;
    for (;;) {
        if (first) wait_vm(6, dep0); else wait_vm((d0 ? 2 : 0) + (d1 ? 6 : 0) + (h2 ? 3 : 0), dep0);
        LBAR();
        first = false;
        const bool h1 = have_st;
        if (have_st) {
            *(v4u*)(ostp) = ost[0]; *(v4u*)(ostp + 32) = ost[1];
            if (g4 == 0) *lstp = lst;
            have_st = false;
        }
        if (k == 0 && tid_ == 0) { const unsigned one_ = 1u; asm volatile("global_atomic_add %0, %1, %2, off sc0" : "=&v"(tkt) : "v"(F.ctl + CW_TICKET), "v"(one_) : "memory"); }
        if (k == 2 && tid_ == 0) { asm volatile("" : "+v"(tkt)); F.MISC[4] = tkt; }
        if (k == 3) { const int tn = __builtin_amdgcn_readfirstlane((int)F.MISC[4]); has_nxt = tn < T_ATTS; if (has_nxt) nxt = aitem_decode(tn - T_ATTP, avar); else tret = tn; }
        const AStep s2 = astep2(cur, nxt, has_nxt, k + 2);
        const bool d2 = s2.valid != 0;
        if (d2) att_dma_slot(F, s2, (sc + 2) & 3, w, lane);
        bf16x8 qf[2];
#pragma unroll
        for (int d0_ = 0; d0_ < 2; ++d0_) qf[d0_] = __builtin_bit_cast(bf16x8, qn[d0_]);
        f32x4 o[4]; f32x4 lacc = {0.f, 0.f, 0.f, 0.f};
#pragma unroll
        for (int dt = 0; dt < 4; ++dt) o[dt] = (f32x4){0.f, 0.f, 0.f, 0.f};
        if (st.compute) {
            const int prev = (sc + 3) & 3;
            if (prev == 3) { if (st.kb == 0) att_compute<true, true>(L, prev, qf, mref, w, lane, o, lacc, avar); else att_compute<false, true>(L, prev, qf, mref, w, lane, o, lacc, avar); }
            else { if (st.kb == 0) att_compute<true, false>(L, prev, qf, mref, w, lane, o, lacc, avar); else att_compute<false, false>(L, prev, qf, mref, w, lane, o, lacc, avar); }
        }
        { unsigned dp = __builtin_bit_cast(unsigned, lacc[0]); wait_vm((d2 ? 4 : 0) + (h1 ? 3 : 0), dp); lacc[0] = __builtin_bit_cast(float, dp); }
        qn[0] = *(const LAS v4u*)(stg + qoff0); qn[1] = *(const LAS v4u*)(stg + qoff1);
        if (st.compute) {
#pragma unroll
            for (int u = 0; u < 4; ++u) { v2u x; x.x = pk2(o[u][0], o[u][1]); x.y = pk2(o[u][2], o[u][3]); *(LAS v2u*)(stg + ql * 128 + (16 * u + 4 * g4) * 2) = x; }
            LDS_WAIT();
            const int sq = lane >> 2, sp = lane & 3;
            ost[0] = *(const LAS v4u*)(stg + sq * 128 + sp * 16); ost[1] = *(const LAS v4u*)(stg + sq * 128 + 64 + sp * 16);
            const size_t qrow = (size_t)st.b * SEQ + (size_t)(128 * st.kb + 16 * w + sq) * st.D + st.r;
            ostp = OP + (size_t)st.g * OPART_STRIDE + qrow * DA + st.h * 64 + sp * 8;
            const size_t lrow = (size_t)st.b * SEQ + (size_t)(128 * st.kb + 16 * w + ql) * st.D + st.r;
            lstp = LP + (size_t)st.g * LPART_STRIDE + lrow * HA + st.h;
            lst = lacc[0];
            have_st = true;
        }
        LDS_WAIT();
        if (d2) att_q_dma(F, s2, w, lane);
        ++sc; ++k; d0 = d1; d1 = d2; h2 = h1;
        if (k == cur.nsteps) { if (!has_nxt) break; cur = nxt; has_nxt = false; k = 0; }
        st = astep(cur, k);
    }
    if (have_st) {
        *(v4u*)(ostp) = ost[0]; *(v4u*)(ostp + 32) = ost[1];
        if (g4 == 0) *lstp = lst;
    }
    VM_WAIT(); LBAR();
    return tret;
}
__device__ __forceinline__ int p2_fetch(Frame& F, int cw) {
    if (F.tid == 0) F.MISC[4] = __hip_atomic_fetch_add(F.ctl + cw, 1u, RLX_AGENT);
    LBAR(); const int t = __builtin_amdgcn_readfirstlane((int)F.MISC[4]); LBAR(); return t;
}
__device__ __forceinline__ void p2_run_a(Frame& F) {
    int t = p2_fetch(F, CW_TICKET_A);
    while (t < N_ATTS + N_GLAS) {
        if (t < N_ATTS) { if (F.item_mask & 2) attn_sample_item(F, t >> 3, t & 7); }
        else { const int i = t - N_ATTS; if (F.item_mask & 4) gla_sample_item(F, i >> 2, i & 3); }
        t = p2_fetch(F, CW_TICKET_A);
    }
}
__device__ __forceinline__ void p2_run_b(Frame& F) {
    if (!(F.item_mask & 8)) return;
    const int t = p2_fetch(F, CW_TICKET);
    if (t < N_ATTP) (void)attn_prompt_loop(F, t);
}
__device__ __forceinline__ void p2_phase(Frame& F) {
#ifdef PROBE_RESTRICT
    if (F.item_mask & 64) {
        if ((int)blockIdx.x < 16) { for (int i = (int)blockIdx.x; i < N_ATTS; i += 16) attn_sample_item(F, i >> 3, i & 7); }
        return;
    }
#endif
    if (F.item_mask & 1) { const int tg = p2_fetch(F, CW_TICKET_G); if (tg < N_GLAP) gla_prompt_item(F, tg >> 2, tg & 3); }
    if ((((int)blockIdx.x >> 3) & 7) < 3) { p2_run_a(F); p2_run_b(F); } else { p2_run_b(F); p2_run_a(F); }
}
struct OneUnit { int pm, pn;
    __device__ __forceinline__ bool next(int i, pg8::Unit& u) const { if (i > 0) return false; u.pm = pm; u.pn = pn; return true; }
    __device__ __forceinline__ void a_ready(const pg8::Unit&) const {}
    __device__ __forceinline__ void done(const pg8::Unit&) const {} };
constexpr int N_SU_IN = (MS / 256) * (NIN / 256), N_SU_OUT = (MS / 256) * (DM / 256);
__device__ __forceinline__ void p2b_combine(Frame& F) {
    const bf16* OP = WSP(bf16, WS_OPART); const float* LP = WSP(float, WS_LPART); const bf16* GAp = WSP(bf16, WS_GA); bf16* MIX = WSP(bf16, WS_MIX);
    const size_t gt = (size_t)(blockIdx.x - N_SU_OUT) * (NWAVES * 64) + F.tid, NGT = (size_t)(F.G - N_SU_OUT) * NWAVES * 64;
    constexpr size_t NIT = (size_t)MP * 64;
    for (size_t it = gt; it < NIT; it += 2 * NGT) {
        const size_t itb = it + NGT; const bool hasb = itb < NIT; const size_t i2 = hasb ? itb : it;
        const size_t tok[2] = {it >> 6, i2 >> 6}; const int c8[2] = {(int)(it & 63), (int)(i2 & 63)};
        v4u x[2][3], gx[2]; float lv[2][3];
#pragma unroll
        for (int e = 0; e < 2; ++e) {
#pragma unroll
            for (int g = 0; g < 3; ++g) { x[e][g] = NTLD((const v4u*)(OP + (size_t)g * OPART_STRIDE + tok[e] * DA + 8 * c8[e])); lv[e][g] = LP[(size_t)g * LPART_STRIDE + tok[e] * HA + (c8[e] >> 3)]; }
            gx[e] = NTLD((const v4u*)(GAp + tok[e] * DA + 8 * c8[e]));
        }
#pragma unroll
        for (int e = 0; e < 2; ++e) {
            if (e == 1 && !hasb) continue;
            f32x4 a = {0.f, 0.f, 0.f, 0.f}, b = {0.f, 0.f, 0.f, 0.f}; float l = 0.f;
#pragma unroll
            for (int g = 0; g < 3; ++g) { a += (f32x4){bflo(x[e][g].x), bfhi(x[e][g].x), bflo(x[e][g].y), bfhi(x[e][g].y)}; b += (f32x4){bflo(x[e][g].z), bfhi(x[e][g].z), bflo(x[e][g].w), bfhi(x[e][g].w)}; l += lv[e][g]; }
            const float rl = 1.0f / l;
            a = a * rl * (f32x4){bflo(gx[e].x), bfhi(gx[e].x), bflo(gx[e].y), bfhi(gx[e].y)}; b = b * rl * (f32x4){bflo(gx[e].z), bfhi(gx[e].z), bflo(gx[e].w), bfhi(gx[e].w)};
            *(v4u*)(MIX + tok[e] * DM + 8 * c8[e]) = pack8(a, b);
        }
    }
}

__device__ __forceinline__ void stagger_start(int c, int n_long, int G, unsigned span_ticks) {
    if (c < n_long || span_ticks == 0u) return;
    const unsigned frac = (unsigned)(((c - n_long) * 97) % (G - n_long));
    const unsigned long long wait = (unsigned long long)span_ticks * frac / (unsigned)(G - n_long), t0 = __builtin_amdgcn_s_memrealtime();
    while (__builtin_amdgcn_s_memrealtime() - t0 < wait) __builtin_amdgcn_s_sleep(16);
}
#ifndef STAG1
#define STAG1 0
#endif
#ifndef STAG3
#define STAG3 0
#endif
#ifndef MK_N_LAUNCHES
#define MK_N_LAUNCHES 6
#endif
constexpr int N_PHASES = 6;
__global__ void __launch_bounds__(NWAVES * 64, 2) hymba_fwd(Args args) {
    extern __shared__ __attribute__((aligned(16))) unsigned char lds[];
    Frame F;
    F.lds = (LAS unsigned char*)lds; F.MISC = (volatile LAS unsigned*)(F.lds + MISC_OFF);
    F.tid = threadIdx.x; F.lane = F.tid & 63; F.wave = __builtin_amdgcn_readfirstlane(F.tid >> 6); F.G = gridDim.x;
    F.item_mask = args.item_mask; F.ws = args.ws; F.ctl = (gu32*)(args.ws + WS_CTL); F.out = args.out;
    for (int u = F.tid; u < (LDS_BYTES - LDSCTL_OFF) / 4; u += NWAVES * 64) ((LAS unsigned*)(F.lds + LDSCTL_OFF))[u] = 0u;
    __syncthreads();
    const int lo = args.ph_lo, hi = args.ph_hi;
    XcdBarrier bar; bar.bar = (unsigned*)(F.ctl + CW_BAR); bar.x = 0; bar.st = nullptr;
    if (hi - lo > 1) bar = xcd_barrier_post((unsigned*)(F.ctl + CW_BAR), F.MISC + 8);
#ifdef ONLY_PHASE
#define IN(k) ((k) == ONLY_PHASE && lo <= (k) && (k) < hi)
#else
#define IN(k) (lo <= (k) && (k) < hi)
#endif
#define BOTH(k) (IN(k) && IN((k) + 1))
    if (IN(0)) {
        p0_prologue(F);
        asm volatile("s_waitcnt vmcnt(0)" ::: "memory"); __syncthreads();
        if (F.tid == 0) { __builtin_amdgcn_fence(__ATOMIC_RELEASE, "agent"); asm volatile("s_waitcnt vmcnt(0)" ::: "memory"); __hip_atomic_fetch_add(F.ctl + CW_P0A, 1u, RLX_AGENT); }
        if (!IN(1) && BOTH(0)) xcd_barrier(bar);
    }
    if (IN(1)) {
        if ((int)blockIdx.x < N_SU_IN) {
            if (IN(0)) {
                if (F.tid == 0) {
                    unsigned sp = 0; bool ok = true;
                    while (__hip_atomic_load(F.ctl + CW_P0A, RLX_AGENT) < (unsigned)F.G) { __builtin_amdgcn_s_sleep(8); if (++sp > (1u << 22)) { ok = false; break; } }
                    if (!ok) __hip_atomic_store(F.ctl + CW_TMO, 1u, RLX_AGENT);
                    __builtin_amdgcn_fence(__ATOMIC_ACQUIRE, "agent"); asm volatile("s_waitcnt vmcnt(0)" ::: "memory");
                }
                __syncthreads();
                __builtin_amdgcn_fence(__ATOMIC_ACQUIRE, "agent"); asm volatile("s_waitcnt vmcnt(0)" ::: "memory");
            }
            pg8::Gemm g{WSP(const pg8::bf16_t, WS_XB), WSP(const pg8::bf16_t, WS_WIN), MTOT, NIN, DM}; OneUnit S{MP / 256 + (int)blockIdx.x / (NIN / 256), (int)blockIdx.x % (NIN / 256)};
            EpiIn E{WSP(const float, WS_RSTD), WSP(const float, WS_ROPE), WSP(const float, WS_SCAL) + 64, INP(I_BGATE), F.ws, F.out, F.lds + OSTAGE_OFF};
            pg8::gemm_phase<EpiIn, OneUnit, false, true>(F.lds + RING_OFF, g, S, E);
        }
        p0b_convert(F);
        if (BOTH(1)) xcd_barrier(bar);
    }
    if (IN(2)) {
        pg8::Gemm g{WSP(const pg8::bf16_t, WS_XB), WSP(const pg8::bf16_t, WS_WIN), MP, NIN, DM}; pg8::StaticOrder S; S.init(MP, NIN, F.G, (int)blockIdx.x, 1);
        EpiIn E{WSP(const float, WS_RSTD), WSP(const float, WS_ROPE), WSP(const float, WS_SCAL) + 64, INP(I_BGATE), F.ws, F.out, F.lds + OSTAGE_OFF};
        stagger_start((int)blockIdx.x, (MP / 256) * (NIN / 256) % F.G, F.G, STAG1);
        pg8::gemm_phase<EpiIn, pg8::StaticOrder, true, true>(F.lds + RING_OFF, g, S, E);
        if (BOTH(2)) xcd_barrier(bar);
    }
    if (IN(3)) { p2_phase(F); if (BOTH(3)) xcd_barrier(bar); }
    if (IN(4)) {
        if ((int)blockIdx.x < N_SU_OUT) {
            pg8::Gemm g{WSP(const pg8::bf16_t, WS_MIX), WSP(const pg8::bf16_t, WS_WOUT), MTOT, DM, DM}; OneUnit S{MP / 256 + (int)blockIdx.x / (DM / 256), (int)blockIdx.x % (DM / 256)};
            EpiOut E{WSP(const bf16, WS_XB), F.out, F.lds + OSTAGE_OFF};
            pg8::gemm_phase<EpiOut, OneUnit, false, true>(F.lds + RING_OFF, g, S, E);
        } else p2b_combine(F);
        if (BOTH(4)) xcd_barrier(bar);
    }
    if (IN(5)) {
        pg8::Gemm g{WSP(const pg8::bf16_t, WS_MIX), WSP(const pg8::bf16_t, WS_WOUT), MP, DM, DM}; pg8::StaticOrder S; S.init(MP, DM, F.G, (int)blockIdx.x);
        EpiOut E{WSP(const bf16, WS_XB), F.out, F.lds + OSTAGE_OFF};
        stagger_start((int)blockIdx.x, (MP / 256) * (DM / 256) % F.G, F.G, STAG3);
        pg8::gemm_phase<EpiOut, pg8::StaticOrder, true, true>(F.lds + RING_OFF, g, S, E);
    }
#undef IN
#undef BOTH
}

extern "C" void kernel_launch(void* const* d_in, const int* in_sizes, int n_in, void* d_out, int out_size, void* d_ws, size_t ws_size, hipStream_t stream) {
    static int grid = 0;
    if (grid == 0) {
        if (n_in != 13 || (size_t)out_size != OUT_END || ws_size < WS_END) { fprintf(stderr, "kernel_launch: unexpected shapes (n_in %d out %d ws %zu)\n", n_in, out_size, ws_size); grid = -1; return; }
        int dev = 0, cus = 0, per_cu = 0;
        if (hipGetDevice(&dev) != hipSuccess || hipDeviceGetAttribute(&cus, hipDeviceAttributeMultiprocessorCount, dev) != hipSuccess) { grid = -1; return; }
        if (hipFuncSetAttribute((const void*)hymba_fwd, hipFuncAttributeMaxDynamicSharedMemorySize, LDS_BYTES) != hipSuccess) { fprintf(stderr, "kernel_launch: hipFuncSetAttribute failed\n"); grid = -1; return; }
        if (hipOccupancyMaxActiveBlocksPerMultiprocessor(&per_cu, (const void*)hymba_fwd, NWAVES * 64, LDS_BYTES) != hipSuccess || per_cu < 1) fprintf(stderr, "kernel_launch: occupancy query reports %d\n", per_cu);
        (void)hipGetLastError();
        grid = cus;
    }
    if (grid < 0) return;
    if (hipMemsetAsync((char*)d_ws + WS_CTL, 0, CTL_ZERO_BYTES, stream) != hipSuccess) return;
    Args a{};
    for (int i = 0; i < 13; ++i) a.in[i] = (const float*)d_in[i];
    a.out = (float*)d_out; a.ws = (unsigned char*)d_ws; a.item_mask = 15;
    constexpr int NL = MK_N_LAUNCHES;
    static_assert(NL == 1 || NL == N_PHASES, "MK_N_LAUNCHES is 1 or 6");
    for (int li = 0; li < NL; ++li) {
        a.ph_lo = (NL == 1) ? 0 : li; a.ph_hi = (NL == 1) ? N_PHASES : li + 1;
        hipLaunchKernelGGL(hymba_fwd, dim3(grid), dim3(NWAVES * 64), LDS_BYTES, stream, a);
        const hipError_t le = hipPeekAtLastError();
        if (le != hipSuccess) { fprintf(stderr, "kernel_launch: launch %d failed: %s\n", li, hipGetErrorName(le)); break; }
    }
#ifdef PROBE_EXTRA_PHASE
    (void)hipMemsetAsync((char*)d_ws + WS_CTL, 0, CTL_ZERO_BYTES, stream);
    a.ph_lo = PROBE_EXTRA_PHASE; a.ph_hi = PROBE_EXTRA_PHASE + 1;
#ifdef PROBE_ITEM_MASK
    a.item_mask = PROBE_ITEM_MASK;
#endif
    hipLaunchKernelGGL(hymba_fwd, dim3(grid), dim3(NWAVES * 64), LDS_BYTES, stream, a);
#endif
}
```
